# Optimizing an MI355X kernel written in HIP

```python
import math
import jax, jax.numpy as jnp
from jax import lax
import numpy as np

D_MODEL = 1024
BATCH = 2
SEQ = 8192
DEPTH = 4

SSM_WIDTH = 512
SSM_GROUP = 16
SSM_GROUPS = SSM_WIDTH // SSM_GROUP
SSM_STATE = 64
MLSTM_HEADS = 4
MLSTM_HEAD_DIM = 128
MLSTM_WIDTH = MLSTM_HEADS * MLSTM_HEAD_DIM
MLSTM_CHUNK = 64
CONV_WIDTH = 4
ATTN_HEADS = 4
ATTN_HEAD_DIM = 128
ATTN_WIDTH = ATTN_HEADS * ATTN_HEAD_DIM
Q_LORA_RANK = 256
IDX_HEADS = 8
IDX_HEAD_DIM = 64
TOPK_MAX = 256
Q_BLOCK = 128
N_BRANCH = 3
BRANCH_WIDTH = 512
EPS = 1e-6

SPLITS = (SSM_WIDTH, SSM_WIDTH,
          MLSTM_WIDTH, MLSTM_WIDTH, MLSTM_WIDTH, MLSTM_HEADS, MLSTM_HEADS, MLSTM_WIDTH,
          Q_LORA_RANK, ATTN_HEAD_DIM, ATTN_HEAD_DIM, IDX_HEAD_DIM, IDX_HEADS, ATTN_WIDTH,
          N_BRANCH * D_MODEL)
IN_WIDTH = sum(SPLITS)

kernel_name = 'hybrid_s5_mlstm_dsa_gated_block'


def rmsnorm(x, g):
    xf = x.astype(jnp.float32)
    y = xf * lax.rsqrt(jnp.mean(xf * xf, axis=-1, keepdims=True) + EPS)
    return (y * g.astype(jnp.float32)).astype(x.dtype)


def layernorm(x, g, b):
    xf = x.astype(jnp.float32)
    mu = jnp.mean(xf, axis=-1, keepdims=True)
    xc = xf - mu
    y = xc * lax.rsqrt(jnp.mean(xc * xc, axis=-1, keepdims=True) + EPS)
    return (y * g.astype(jnp.float32) + b.astype(jnp.float32)).astype(x.dtype)


def causal_depthwise_conv(x, w, b):
    k_w, ch = w.shape
    y = lax.conv_general_dilated(x, w[:, None, :], window_strides=(1,), padding=[(k_w - 1, 0)],
                                 dimension_numbers=('NWC', 'WIO', 'NWC'), feature_group_count=ch)
    return y + b


def s5_mixer(u, a_re, a_im, b_re, b_im, c_re, c_im, log_dt, d_skip, glu_w, glu_b):
    bsz, seq, _ = u.shape
    f32 = jnp.float32
    uf = u.astype(f32).reshape(bsz, seq, SSM_GROUPS, SSM_GROUP)
    dt = jnp.exp(log_dt.astype(f32))[:, None]
    ar = a_re.astype(f32)
    ai = a_im.astype(f32)
    mag = jnp.exp(ar * dt)
    ang = ai * dt
    abar_re = mag * jnp.cos(ang)
    abar_im = mag * jnp.sin(ang)
    den = ar * ar + ai * ai
    fr = ((abar_re - 1.0) * ar + abar_im * ai) / den
    fi = (abar_im * ar - (abar_re - 1.0) * ai) / den
    br = b_re.astype(f32)
    bi = b_im.astype(f32)
    bb_re = fr[..., None] * br - fi[..., None] * bi
    bb_im = fr[..., None] * bi + fi[..., None] * br
    bu_re = jnp.einsum('blgp,gnp->blgn', uf, bb_re)
    bu_im = jnp.einsum('blgp,gnp->blgn', uf, bb_im)
    a_seq_re = jnp.broadcast_to(abar_re, bu_re.shape)
    a_seq_im = jnp.broadcast_to(abar_im, bu_im.shape)

    def combine(e1, e2):
        a1r, a1i, b1r, b1i = e1
        a2r, a2i, b2r, b2i = e2
        return (a2r * a1r - a2i * a1i, a2r * a1i + a2i * a1r,
                a2r * b1r - a2i * b1i + b2r, a2r * b1i + a2i * b1r + b2i)

    _, _, h_re, h_im = lax.associative_scan(combine, (a_seq_re, a_seq_im, bu_re, bu_im), axis=1)
    y = (jnp.einsum('blgn,gpn->blgp', h_re, c_re.astype(f32))
         - jnp.einsum('blgn,gpn->blgp', h_im, c_im.astype(f32)))
    y = y.reshape(bsz, seq, SSM_WIDTH) + d_skip.astype(f32) * u.astype(f32)
    g = jax.nn.gelu(y)
    out = g * jax.nn.sigmoid(g @ glu_w.astype(f32) + glu_b.astype(f32))
    return out.astype(u.dtype)


def mlstm_mixer(q, k, v, i_pre, f_pre, conv_w, conv_b, igate_b, fgate_b, mh_norm_g):
    bsz, seq, _ = q.shape
    f32 = jnp.float32
    qk = jax.nn.silu(causal_depthwise_conv(jnp.concatenate([q, k], axis=-1), conv_w, conv_b))
    q, k = jnp.split(qk, 2, axis=-1)
    nc = seq // MLSTM_CHUNK

    def to_chunks(t):
        t = t.astype(f32).reshape(bsz, nc, MLSTM_CHUNK, MLSTM_HEADS, -1)
        return t.transpose(1, 0, 3, 2, 4)

    def gates_to_chunks(t):
        return t.reshape(bsz, nc, MLSTM_CHUNK, MLSTM_HEADS).transpose(1, 0, 3, 2)

    qc = to_chunks(q)
    kc = to_chunks(k) * (MLSTM_HEAD_DIM ** -0.5)
    vc = to_chunks(v)
    ig = gates_to_chunks(i_pre.astype(f32) + igate_b.astype(f32))
    lf = gates_to_chunks(jax.nn.log_sigmoid(f_pre.astype(f32) + fgate_b.astype(f32)))
    causal = jnp.tril(jnp.ones((MLSTM_CHUNK, MLSTM_CHUNK), dtype=bool))

    def step(carry, xs):
        c_prev, n_prev, m_prev = carry
        qb, kb, vb, ib, fb = xs
        bcum = jnp.cumsum(fb, axis=-1)
        dmat = bcum[..., :, None] - bcum[..., None, :] + ib[..., None, :]
        dmat = jnp.where(causal, dmat, -jnp.inf)
        inter = bcum + m_prev[..., None]
        m = jnp.maximum(inter, jnp.max(dmat, axis=-1))
        dexp = jnp.exp(dmat - m[..., None])
        inter_w = jnp.exp(inter - m)
        s = jnp.einsum('bhtd,bhsd->bhts', qb, kb) * dexp
        num = (jnp.einsum('bhts,bhse->bhte', s, vb)
               + inter_w[..., None] * jnp.einsum('bhtd,bhde->bhte', qb, c_prev))
        den = jnp.sum(s, axis=-1) + inter_w * jnp.einsum('bhtd,bhd->bht', qb, n_prev)
        h = num / jnp.maximum(jnp.abs(den), jnp.exp(-m))[..., None]
        b_last = bcum[..., -1]
        g_end = b_last[..., None] - bcum + ib
        m_next = jnp.maximum(b_last + m_prev, jnp.max(g_end, axis=-1))
        w_s = jnp.exp(g_end - m_next[..., None])
        decay = jnp.exp(b_last + m_prev - m_next)
        c_next = decay[..., None, None] * c_prev + jnp.einsum('bhs,bhsd,bhse->bhde', w_s, kb, vb)
        n_next = decay[..., None] * n_prev + jnp.einsum('bhs,bhsd->bhd', w_s, kb)
        return (c_next, n_next, m_next), h

    init = (jnp.zeros((bsz, MLSTM_HEADS, MLSTM_HEAD_DIM, MLSTM_HEAD_DIM), f32),
            jnp.zeros((bsz, MLSTM_HEADS, MLSTM_HEAD_DIM), f32),
            jnp.zeros((bsz, MLSTM_HEADS), f32))
    _, hs = lax.scan(step, init, (qc, kc, vc, ig, lf))
    h = hs.transpose(1, 0, 3, 2, 4).reshape(bsz, seq, MLSTM_HEADS, MLSTM_HEAD_DIM)
    h = h * lax.rsqrt(jnp.mean(h * h, axis=-1, keepdims=True) + EPS)
    h = h.reshape(bsz, seq, MLSTM_WIDTH) * mh_norm_g.astype(f32)
    return h.astype(q.dtype)


def dsa_mixer(cq, k, v, kidx, widx, q_norm_g, w_uq, w_qidx, kidx_norm_g, kidx_norm_b):
    bsz, seq, _ = cq.shape
    f32 = jnp.float32
    cqn = rmsnorm(cq, q_norm_g)
    q = (cqn @ w_uq).reshape(bsz, seq, ATTN_HEADS, ATTN_HEAD_DIM)
    qi = (cqn @ w_qidx).reshape(bsz, seq, IDX_HEADS, IDX_HEAD_DIM)
    ki = layernorm(kidx, kidx_norm_g, kidx_norm_b).astype(f32)
    wi = widx.astype(f32) * (IDX_HEADS ** -0.5) * (IDX_HEAD_DIM ** -0.5)
    topk = min(TOPK_MAX, seq // 4)
    nb = seq // Q_BLOCK
    q_blk = q.reshape(bsz, nb, Q_BLOCK, ATTN_HEADS, ATTN_HEAD_DIM).transpose(1, 0, 2, 3, 4)
    qi_blk = qi.reshape(bsz, nb, Q_BLOCK, IDX_HEADS, IDX_HEAD_DIM).transpose(1, 0, 2, 3, 4)
    wi_blk = wi.reshape(bsz, nb, Q_BLOCK, IDX_HEADS).transpose(1, 0, 2, 3)
    starts = jnp.arange(nb, dtype=jnp.int32) * Q_BLOCK
    s_pos = jnp.arange(seq, dtype=jnp.int32)
    gather = jax.vmap(lambda kb_, ib_: kb_[ib_])

    def block(args):
        start, qb, qib, wb = args
        t = start + jnp.arange(Q_BLOCK, dtype=jnp.int32)
        rel = jax.nn.relu(jnp.einsum('bthd,bsd->bths', qib.astype(f32), ki))
        score = jnp.einsum('bth,bths->bts', wb, rel)
        causal = s_pos[None, :] <= t[:, None]
        score = jnp.where(causal[None], score, -jnp.inf)
        _, sel = lax.top_k(score, topk)
        valid = sel <= t[None, :, None]
        kg = gather(k, sel).astype(f32)
        vg = gather(v, sel).astype(f32)
        logits = jnp.einsum('bthd,btkd->bthk', qb.astype(f32), kg) * (ATTN_HEAD_DIM ** -0.5)
        logits = jnp.where(valid[:, :, None, :], logits, -jnp.inf)
        p = jax.nn.softmax(logits, axis=-1)
        return jnp.einsum('bthk,btkd->bthd', p, vg)

    o = lax.map(block, (starts, q_blk, qi_blk, wi_blk))
    o = o.transpose(1, 0, 2, 3, 4).reshape(bsz, seq, ATTN_WIDTH)
    return o.astype(cq.dtype)


def hybrid_layer(x, norm_g, w_in, ssm_a_re, ssm_a_im, ssm_b_re, ssm_b_im, ssm_c_re, ssm_c_im,
                 ssm_log_dt, ssm_d, glu_w, glu_b, qk_conv_w, qk_conv_b, igate_b, fgate_b,
                 mh_norm_g, q_norm_g, w_uq, w_qidx, kidx_norm_g, kidx_norm_b, w_branch, w_out):
    bsz, seq, _ = x.shape
    h = rmsnorm(x, norm_g)
    proj = h @ w_in
    idx = np.cumsum(np.array(SPLITS))[:-1].tolist()
    (u_a, z_a, q_b, k_b, v_b, i_b, f_b, z_b,
     cq_c, k_c, v_c, kidx_c, widx_c, z_c, gate_pre) = jnp.split(proj, idx, axis=-1)
    y_a = s5_mixer(u_a, ssm_a_re, ssm_a_im, ssm_b_re, ssm_b_im, ssm_c_re, ssm_c_im,
                   ssm_log_dt, ssm_d, glu_w, glu_b) * jax.nn.silu(z_a)
    y_b = mlstm_mixer(q_b, k_b, v_b, i_b, f_b, qk_conv_w, qk_conv_b, igate_b, fgate_b,
                      mh_norm_g) * jax.nn.silu(z_b)
    y_c = dsa_mixer(cq_c, k_c, v_c, kidx_c, widx_c, q_norm_g, w_uq, w_qidx,
                    kidx_norm_g, kidx_norm_b) * jax.nn.silu(z_c)
    ys = jnp.stack([y_a, y_b, y_c], axis=2)
    branch = jnp.einsum('blnw,nwd->blnd', ys, w_branch)
    gates = jax.nn.sigmoid(gate_pre.reshape(bsz, seq, N_BRANCH, D_MODEL))
    merged = jnp.sum(gates * branch, axis=2)
    return x + merged @ w_out


def setup_inputs(seed: int = 0) -> dict:
    key = jax.random.key(seed)
    ks = jax.random.split(key, 32)
    f32 = jnp.float32
    L_, D_ = DEPTH, D_MODEL
    G, N, P = SSM_GROUPS, SSM_STATE, SSM_GROUP

    def nrm(k, shape, scale):
        return jax.random.normal(k, shape, f32) * scale

    n_idx = jnp.arange(N, dtype=f32)
    inp = {}
    inp['x'] = jax.random.normal(ks[0], (BATCH, SEQ, D_), f32)
    inp['norm_g'] = 1.0 + nrm(ks[1], (L_, D_), 0.02)
    inp['w_in'] = nrm(ks[2], (L_, D_, IN_WIDTH), D_ ** -0.5)
    inp['ssm_a_re'] = -0.5 + nrm(ks[3], (L_, G, N), 0.01)
    inp['ssm_a_im'] = math.pi * n_idx + nrm(ks[4], (L_, G, N), 0.01)
    inp['ssm_b_re'] = nrm(ks[5], (L_, G, N, P), (2.0 * P) ** -0.5)
    inp['ssm_b_im'] = nrm(ks[6], (L_, G, N, P), (2.0 * P) ** -0.5)
    inp['ssm_c_re'] = nrm(ks[7], (L_, G, P, N), (2.0 * N) ** -0.5)
    inp['ssm_c_im'] = nrm(ks[8], (L_, G, P, N), (2.0 * N) ** -0.5)
    inp['ssm_log_dt'] = jax.random.uniform(ks[9], (L_, G), f32, math.log(1e-3), math.log(1e-1))
    inp['ssm_d'] = nrm(ks[10], (L_, SSM_WIDTH), 1.0)
    inp['glu_w'] = nrm(ks[11], (L_, SSM_WIDTH, SSM_WIDTH), SSM_WIDTH ** -0.5)
    inp['glu_b'] = nrm(ks[12], (L_, SSM_WIDTH), 0.02)
    inp['qk_conv_w'] = nrm(ks[13], (L_, CONV_WIDTH, 2 * MLSTM_WIDTH), CONV_WIDTH ** -0.5)
    inp['qk_conv_b'] = nrm(ks[14], (L_, 2 * MLSTM_WIDTH), 0.02)
    inp['igate_b'] = nrm(ks[15], (L_, MLSTM_HEADS), 0.1)
    inp['fgate_b'] = jnp.linspace(3.0, 6.0, MLSTM_HEADS, dtype=f32) + nrm(ks[16], (L_, MLSTM_HEADS), 0.1)
    inp['mh_norm_g'] = 1.0 + nrm(ks[17], (L_, MLSTM_WIDTH), 0.02)
    inp['q_norm_g'] = 1.0 + nrm(ks[18], (L_, Q_LORA_RANK), 0.02)
    inp['w_uq'] = nrm(ks[19], (L_, Q_LORA_RANK, ATTN_WIDTH), Q_LORA_RANK ** -0.5)
    inp['w_qidx'] = nrm(ks[20], (L_, Q_LORA_RANK, IDX_HEADS * IDX_HEAD_DIM), Q_LORA_RANK ** -0.5)
    inp['kidx_norm_g'] = 1.0 + nrm(ks[21], (L_, IDX_HEAD_DIM), 0.02)
    inp['kidx_norm_b'] = nrm(ks[22], (L_, IDX_HEAD_DIM), 0.02)
    inp['w_branch'] = nrm(ks[23], (L_, N_BRANCH, BRANCH_WIDTH, D_), BRANCH_WIDTH ** -0.5)
    inp['w_out'] = nrm(ks[24], (L_, D_, D_), D_ ** -0.5)
    inp['final_norm_g'] = 1.0 + nrm(ks[25], (D_,), 0.02)
    return inp


def reference(x, norm_g, w_in, ssm_a_re, ssm_a_im, ssm_b_re, ssm_b_im, ssm_c_re, ssm_c_im,
              ssm_log_dt, ssm_d, glu_w, glu_b, qk_conv_w, qk_conv_b, igate_b, fgate_b,
              mh_norm_g, q_norm_g, w_uq, w_qidx, kidx_norm_g, kidx_norm_b, w_branch, w_out,
              final_norm_g):
    for l in range(DEPTH):
        x = hybrid_layer(x, norm_g[l], w_in[l], ssm_a_re[l], ssm_a_im[l], ssm_b_re[l], ssm_b_im[l],
                         ssm_c_re[l], ssm_c_im[l], ssm_log_dt[l], ssm_d[l], glu_w[l], glu_b[l],
                         qk_conv_w[l], qk_conv_b[l], igate_b[l], fgate_b[l], mh_norm_g[l],
                         q_norm_g[l], w_uq[l], w_qidx[l], kidx_norm_g[l], kidx_norm_b[l],
                         w_branch[l], w_out[l])
    return rmsnorm(x, final_norm_g)
```

```cpp
#include <hip/hip_runtime.h>
#include <hip/hip_bf16.h>
#include <hip/hip_cooperative_groups.h>
#include <cstdio>
namespace cg = cooperative_groups;

#define DEVI __device__ __forceinline__
typedef unsigned short bf16_t;
typedef __attribute__((ext_vector_type(8))) short bf16x8;
typedef __attribute__((ext_vector_type(16))) float f32x16;
typedef __attribute__((ext_vector_type(4))) float f32x4;
typedef __attribute__((ext_vector_type(4))) unsigned u32x4;

constexpr int D = 1024, SEQ = 8192, NB = 2, T = NB * SEQ, DEPTH = 4;
constexpr int INW = 7248;
constexpr int N1 = 4224;
constexpr int NWIN = 7296;
constexpr int PJ = 4224;
constexpr int C_UA = 0, C_ZA = 512, C_QB = 1024, C_KB = 1536, C_VB = 2048, C_ZB = 2560, C_CQ = 3072,
              C_KC = 3328, C_VC = 3456, C_KIDX = 3584, C_ZC = 3648, C_SMALL = 4160;
constexpr float EPS = 1e-6f;

constexpr size_t SZ_WIN = (size_t)DEPTH * NWIN * 1024 * 2;
constexpr size_t SZ_WGLU = (size_t)DEPTH * 512 * 512 * 2;
constexpr size_t SZ_WQ = (size_t)DEPTH * 1024 * 256 * 2;
constexpr size_t SZ_WBR = (size_t)DEPTH * 3 * 1024 * 512 * 2;
constexpr size_t SZ_WOUT = (size_t)DEPTH * 1024 * 1024 * 2;
constexpr size_t OFF_WIN = 0;
constexpr size_t OFF_WGLU = OFF_WIN + SZ_WIN;
constexpr size_t OFF_WQ = OFF_WGLU + SZ_WGLU;
constexpr size_t OFF_WBR = OFF_WQ + SZ_WQ;
constexpr size_t OFF_WOUT = OFF_WBR + SZ_WBR;
constexpr size_t OFF_XB = OFF_WOUT + SZ_WOUT;
constexpr size_t OFF_ROWSQ = OFF_XB + (size_t)T * 1024 * 2;
constexpr size_t OFF_PROJ = OFF_ROWSQ + (size_t)T * 8 * 4;
constexpr size_t OFF_SMALL = OFF_PROJ + (size_t)T * PJ * 2;
constexpr size_t OFF_QQ = OFF_SMALL + (size_t)T * 16 * 4;
constexpr size_t OFF_KI = OFF_QQ + (size_t)T * 1024 * 2;
constexpr size_t OFF_VT = OFF_KI + (size_t)T * 64 * 2;
constexpr size_t OFF_S5ST = OFF_VT + (size_t)NB * 128 * SEQ * 2;
constexpr size_t OFF_MCT = OFF_S5ST + (size_t)NB * 32 * 128 * 64 * 8;
constexpr size_t OFF_MN = OFF_MCT + (size_t)8 * 128 * 128 * 128 * 2;
constexpr size_t OFF_MSC = OFF_MN + (size_t)8 * 128 * 128 * 4;
constexpr size_t OFF_YG = OFF_MSC + (size_t)3 * 8 * 128 * 4;
constexpr size_t OFF_YS = OFF_YG + (size_t)T * 512 * 2;
constexpr size_t OFF_BAR = OFF_YS + (size_t)3 * T * 512 * 2;
constexpr size_t OFF_GATES = OFF_BAR + 4096;
constexpr size_t OFF_KMAX = OFF_GATES + (size_t)T * 3072;
constexpr size_t WS_TOTAL = OFF_KMAX + 256;

constexpr int SMEM_BYTES = 59392;

struct Params {
  const float* in[26];
  float* out;
  char* ws;
};

DEVI int tidx() { int t = threadIdx.x; asm volatile("" : "+v"(t)); return t; }
typedef float f32x2_t __attribute__((ext_vector_type(2)));
typedef __bf16 bf16x2_t __attribute__((ext_vector_type(2)));
DEVI bf16_t f2bf(float f) {
  __bf16 h = (__bf16)f;
  return __builtin_bit_cast(unsigned short, h);
}
DEVI float bf2f(bf16_t h) { return __uint_as_float(((unsigned)h) << 16); }
DEVI unsigned pack2(float a, float b) {
  f32x2_t v = {a, b};
  bf16x2_t h = __builtin_convertvector(v, bf16x2_t);
  return __builtin_bit_cast(unsigned, h);
}
DEVI float lo2f(unsigned u) { return __uint_as_float(u << 16); }
DEVI float hi2f(unsigned u) { return __uint_as_float(u & 0xffff0000u); }
DEVI float sigmf(float x) { return __builtin_amdgcn_rcpf(1.f + __expf(-x)); }
DEVI float siluf(float x) { return x * sigmf(x); }
DEVI float geluf(float x) {
  float u = 0.7978845608028654f * (x + 0.044715f * x * x * x);
  return x * sigmf(2.f * u);
}
DEVI f32x16 mfma32(bf16x8 a, bf16x8 b, f32x16 c) { return __builtin_amdgcn_mfma_f32_32x32x16_bf16(a, b, c, 0, 0, 0); }
DEVI f32x4 mfma16(bf16x8 a, bf16x8 b, f32x4 c) { return __builtin_amdgcn_mfma_f32_16x16x32_bf16(a, b, c, 0, 0, 0); }
DEVI bf16x8 ld8(const bf16_t* p) { return *(const bf16x8*)p; }
DEVI float shx32(float v) { return __shfl_xor(v, 32, 64); }
DEVI void unpack8(uint4 v, float* f) {
  f[0] = lo2f(v.x); f[1] = hi2f(v.x); f[2] = lo2f(v.y); f[3] = hi2f(v.y);
  f[4] = lo2f(v.z); f[5] = hi2f(v.z); f[6] = lo2f(v.w); f[7] = hi2f(v.w);
}

constexpr int GLD = 72;
template <int NI>
DEVI void gemm_mainloop(const bf16_t* __restrict__ A, int lda, const bf16_t* __restrict__ Bt, int ldb, int K,
                        char* smem, f32x16 (&acc)[NI][2]) {
  bf16_t* sA = (bf16_t*)smem;
  bf16_t* sB = sA + 128 * GLD;
  const int tid = tidx(), lane = tid & 63, w = tid >> 6;
  const int wm = w & 1, wn = w >> 1;
  const int r = lane & 31, hh = lane >> 5;
  u32x4 ra0, ra1, ra2, ra3, rb0, rb1, rb2, rb3;
  const int lrow = tid >> 3, lcol = (tid & 7) * 8;
  const bf16_t* Ap = A + (size_t)lrow * lda + lcol;
  const bf16_t* Bp = Bt + (size_t)lrow * ldb + lcol;
  ra0 = *(const u32x4*)(Ap); ra1 = *(const u32x4*)(Ap + (size_t)32 * lda);
  ra2 = *(const u32x4*)(Ap + (size_t)64 * lda); ra3 = *(const u32x4*)(Ap + (size_t)96 * lda);
  rb0 = *(const u32x4*)(Bp); rb1 = *(const u32x4*)(Bp + (size_t)32 * ldb);
  if (NI == 2) { rb2 = *(const u32x4*)(Bp + (size_t)64 * ldb); rb3 = *(const u32x4*)(Bp + (size_t)96 * ldb); }
  bf16_t* sAw = sA + lrow * GLD + lcol;
  bf16_t* sBw = sB + lrow * GLD + lcol;
  for (int k0 = 0; k0 < K; k0 += 64) {
    __syncthreads();
    *(u32x4*)(sAw) = ra0; *(u32x4*)(sAw + 32 * GLD) = ra1; *(u32x4*)(sAw + 64 * GLD) = ra2; *(u32x4*)(sAw + 96 * GLD) = ra3;
    *(u32x4*)(sBw) = rb0; *(u32x4*)(sBw + 32 * GLD) = rb1;
    if (NI == 2) { *(u32x4*)(sBw + 64 * GLD) = rb2; *(u32x4*)(sBw + 96 * GLD) = rb3; }
    __syncthreads();
    if (k0 + 64 < K) {
      Ap += 64; Bp += 64;
      ra0 = *(const u32x4*)(Ap); ra1 = *(const u32x4*)(Ap + (size_t)32 * lda);
      ra2 = *(const u32x4*)(Ap + (size_t)64 * lda); ra3 = *(const u32x4*)(Ap + (size_t)96 * lda);
      rb0 = *(const u32x4*)(Bp); rb1 = *(const u32x4*)(Bp + (size_t)32 * ldb);
      if (NI == 2) { rb2 = *(const u32x4*)(Bp + (size_t)64 * ldb); rb3 = *(const u32x4*)(Bp + (size_t)96 * ldb); }
    }
#pragma unroll
    for (int ks = 0; ks < 4; ks++) {
      bf16x8 af[2], bfr[NI];
#pragma unroll
      for (int i = 0; i < 2; i++) af[i] = ld8(sA + (wm * 64 + i * 32 + r) * GLD + ks * 16 + hh * 8);
#pragma unroll
      for (int i = 0; i < NI; i++) bfr[i] = ld8(sB + (wn * 32 * NI + i * 32 + r) * GLD + ks * 16 + hh * 8);
#pragma unroll
      for (int ni = 0; ni < NI; ni++)
#pragma unroll
        for (int mi = 0; mi < 2; mi++) acc[ni][mi] = mfma32(bfr[ni], af[mi], acc[ni][mi]);
    }
  }
}
template <int NI, class Epi>
DEVI void gemm_epilogue(f32x16 (&acc)[NI][2], Epi epi) {
  const int tid = tidx(), lane = tid & 63, w = tid >> 6;
  const int wm = w & 1, wn = w >> 1;
  const int r = lane & 31, hh = lane >> 5;
#pragma unroll
  for (int ni = 0; ni < NI; ni++)
#pragma unroll
    for (int mi = 0; mi < 2; mi++)
#pragma unroll
      for (int g = 0; g < 4; g++) {
        f32x4 v = {acc[ni][mi][4 * g], acc[ni][mi][4 * g + 1], acc[ni][mi][4 * g + 2], acc[ni][mi][4 * g + 3]};
        epi(wm * 64 + mi * 32 + r, wn * 32 * NI + ni * 32 + 8 * g + 4 * hh, v);
      }
}
template <int NI>
DEVI void zero_acc(f32x16 (&acc)[NI][2]) {
#pragma unroll
  for (int a = 0; a < NI; a++)
#pragma unroll
    for (int b = 0; b < 2; b++)
#pragma unroll
      for (int i = 0; i < 16; i++) acc[a][b][i] = 0.f;
}

DEVI int inmap(int n) {
  if (n < 2560) return n;
  if (n < 3648) return n + 8;
  if (n < 4160) return n + 16;
  if (n < 4168) return 2560 + (n - 4160);
  if (n < 4176) return 3656 + (n - 4168);
  if (n < 4224) return -1;
  return 4176 + (n - 4224);
}
DEVI void convT_tile(const float* __restrict__ src, int ld_src, const float* __restrict__ ksc, bf16_t* __restrict__ dst,
                     int K, int n0, int k0, bool use_map, char* smem) {
  bf16_t* s = (bf16_t*)smem;
  const int tid = tidx();
#pragma unroll
  for (int i = 0; i < 4; i++) {
    const int e = tid + 256 * i;
    const int kk = e >> 4, n4 = (e & 15) * 4;
    const int col = use_map ? inmap(n0 + n4) : (n0 + n4);
    float4 v = {0.f, 0.f, 0.f, 0.f};
    if (col >= 0) {
      v = *(const float4*)(src + (size_t)(k0 + kk) * ld_src + col);
      if (ksc) { const float g = ksc[k0 + kk]; v.x *= g; v.y *= g; v.z *= g; v.w *= g; }
    }
    s[(n4 + 0) * 72 + kk] = f2bf(v.x);
    s[(n4 + 1) * 72 + kk] = f2bf(v.y);
    s[(n4 + 2) * 72 + kk] = f2bf(v.z);
    s[(n4 + 3) * 72 + kk] = f2bf(v.w);
  }
  __syncthreads();
#pragma unroll
  for (int i = 0; i < 2; i++) {
    int e = tid + 256 * i;
    int nn = e >> 3, c8 = e & 7;
    *(uint4*)(dst + (size_t)(n0 + nn) * K + k0 + c8 * 8) = *(const uint4*)(s + nn * 72 + c8 * 8);
  }
  __syncthreads();
}

DEVI void phase0(const Params& p, char* smem) {
  char* ws = p.ws;
  const int NT_IN = 4 * 114 * 16, NT_GLU = 4 * 64, NT_Q = 4 * 64, NT_BR = 4 * 384, NT_OUT = 4 * 256;
  const int total = NT_IN + NT_GLU + NT_Q + NT_BR + NT_OUT;
  for (int id = blockIdx.x; id < total; id += gridDim.x) {
    int j = id;
    if (j < NT_IN) {
      int l = j / (114 * 16), rr = j % (114 * 16);
      int nt = rr / 16, kt = rr % 16;
      convT_tile(p.in[2] + (size_t)l * 1024 * INW, INW, p.in[1] + l * 1024,
                 (bf16_t*)(ws + OFF_WIN) + (size_t)l * NWIN * 1024, 1024, nt * 64, kt * 64, true, smem);
      continue;
    }
    j -= NT_IN;
    if (j < NT_GLU) {
      int l = j / 64, rr = j % 64;
      convT_tile(p.in[11] + (size_t)l * 512 * 512, 512, nullptr, (bf16_t*)(ws + OFF_WGLU) + (size_t)l * 512 * 512, 512,
                 (rr / 8) * 64, (rr % 8) * 64, false, smem);
      continue;
    }
    j -= NT_GLU;
    if (j < NT_Q) {
      int l = j / 64, rr = j % 64;
      int which = rr / 32, r2 = rr % 32;
      const float* src = (which ? p.in[20] : p.in[19]) + (size_t)l * 256 * 512;
      convT_tile(src, 512, p.in[18] + l * 256, (bf16_t*)(ws + OFF_WQ) + (size_t)l * 1024 * 256 + (size_t)which * 512 * 256,
                 256, (r2 / 4) * 64, (r2 % 4) * 64, false, smem);
      continue;
    }
    j -= NT_Q;
    if (j < NT_BR) {
      int l = j / 384, rr = j % 384;
      int n = rr / 128, r2 = rr % 128;
      convT_tile(p.in[23] + ((size_t)l * 3 + n) * 512 * 1024, 1024, nullptr,
                 (bf16_t*)(ws + OFF_WBR) + ((size_t)l * 3 + n) * 1024 * 512, 512, (r2 / 8) * 64, (r2 % 8) * 64, false, smem);
      continue;
    }
    j -= NT_BR;
    {
      int l = j / 256, rr = j % 256;
      convT_tile(p.in[24] + (size_t)l * 1024 * 1024, 1024, nullptr, (bf16_t*)(ws + OFF_WOUT) + (size_t)l * 1024 * 1024,
                 1024, (rr / 16) * 64, (rr % 16) * 64, false, smem);
    }
  }
  const int lane = tidx() & 63, w = tidx() >> 6;
  bf16_t* xb = (bf16_t*)(ws + OFF_XB);
  float* rowsq = (float*)(ws + OFF_ROWSQ);
  for (int row = blockIdx.x * 4 + w; row < T; row += gridDim.x * 4) {
    const float* xr = p.in[0] + (size_t)row * 1024;
    float ss = 0.f;
#pragma unroll
    for (int i = 0; i < 4; i++) {
      float4 v = *(const float4*)(xr + i * 256 + lane * 4);
      *(float4*)(p.out + (size_t)row * 1024 + i * 256 + lane * 4) = v;
      uint2 pk = {pack2(v.x, v.y), pack2(v.z, v.w)};
      *(uint2*)(xb + (size_t)row * 1024 + i * 256 + lane * 4) = pk;
      ss += v.x * v.x + v.y * v.y + v.z * v.z + v.w * v.w;
    }
#pragma unroll
    for (int o = 32; o > 0; o >>= 1) ss += __shfl_xor(ss, o, 64);
    if (lane < 8) rowsq[(size_t)row * 8 + lane] = (lane == 0) ? ss : 0.f;
  }
}

DEVI void load_rowscale(const Params& p, int m0, float* rsc) {
  const float* rowsq = (const float*)(p.ws + OFF_ROWSQ);
  if (tidx() < 128) {
    const float4 a = *(const float4*)(rowsq + (size_t)(m0 + tidx()) * 8);
    const float4 b = *(const float4*)(rowsq + (size_t)(m0 + tidx()) * 8 + 4);
    float s = ((a.x + a.y) + (a.z + a.w)) + ((b.x + b.y) + (b.z + b.w));
    rsc[tidx()] = rsqrtf(s * (1.f / 1024.f) + EPS);
  }
}

DEVI void phase1(const Params& p, int l, char* smem) {
  char* ws = p.ws;
  const bf16_t* xb = (const bf16_t*)(ws + OFF_XB);
  const bf16_t* W = (const bf16_t*)(ws + OFF_WIN) + (size_t)l * NWIN * 1024;
  bf16_t* projb = (bf16_t*)(ws + OFF_PROJ);
  float* small = (float*)(ws + OFF_SMALL);
  unsigned char* gates = (unsigned char*)(ws + OFF_GATES);
  float* rsc = (float*)(smem + 2 * 128 * GLD * 2);
  for (int id = blockIdx.x; id < 128 * 57; id += gridDim.x) {
    const int mt = id / 57, nt = id % 57;
    const int m0 = mt * 128, n0 = nt * 128;
    __syncthreads();
    load_rowscale(p, m0, rsc);
    f32x16 acc[2][2];
    zero_acc<2>(acc);
    gemm_mainloop<2>(xb + (size_t)m0 * 1024, 1024, W + (size_t)n0 * 1024, 1024, 1024, smem, acc);
    if (nt == 32) {
      gemm_epilogue<2>(acc, [&](int ml, int nl, f32x4 v) {
        const float rs = rsc[ml];
        const int m = m0 + ml, n = n0 + nl;
        if (n < C_SMALL) {
          uint2 pk = {pack2(v[0] * rs, v[1] * rs), pack2(v[2] * rs, v[3] * rs)};
          *(uint2*)(projb + (size_t)m * PJ + n) = pk;
        } else if (n < C_SMALL + 16) {
          float4 o = {v[0] * rs, v[1] * rs, v[2] * rs, v[3] * rs};
          *(float4*)(small + (size_t)m * 16 + (n - C_SMALL)) = o;
        }
      });
    } else if (nt < 32) {
      bf16_t* sT = (bf16_t*)smem;
      __syncthreads();
      gemm_epilogue<2>(acc, [&](int ml, int nl, f32x4 v) {
        const float rs = rsc[ml];
        uint2 pk = {pack2(v[0] * rs, v[1] * rs), pack2(v[2] * rs, v[3] * rs)};
        *(uint2*)(sT + ml * 136 + nl) = pk;
      });
      __syncthreads();
      const int tid = tidx();
#pragma unroll
      for (int j = 0; j < 8; j++) {
        const int c = tid + 256 * j;
        const int row = c >> 4, col = (c & 15) * 8;
        *(uint4*)(projb + (size_t)(m0 + row) * PJ + n0 + col) = *(const uint4*)(sT + row * 136 + col);
      }
    } else {
      unsigned char* sG = (unsigned char*)smem;
      __syncthreads();
      gemm_epilogue<2>(acc, [&](int ml, int nl, f32x4 v) {
        const float rs = rsc[ml];
        const unsigned g0 = (unsigned)(sigmf(v[0] * rs) * 255.f + 0.5f), g1 = (unsigned)(sigmf(v[1] * rs) * 255.f + 0.5f);
        const unsigned g2 = (unsigned)(sigmf(v[2] * rs) * 255.f + 0.5f), g3 = (unsigned)(sigmf(v[3] * rs) * 255.f + 0.5f);
        *(unsigned*)(sG + ml * 144 + nl) = g0 | (g1 << 8) | (g2 << 16) | (g3 << 24);
      });
      __syncthreads();
      const int tid = tidx();
      const int gn0 = n0 - N1;
#pragma unroll
      for (int j = 0; j < 4; j++) {
        const int c = tid + 256 * j;
        const int row = c >> 3, col = (c & 7) * 16;
        *(uint4*)(gates + (size_t)(m0 + row) * 3072 + gn0 + col) = *(const uint4*)(sG + row * 144 + col);
      }
    }
  }
}

DEVI void s5_abar(const Params& p, int l, int g, int n, float& abr, float& abi, float& fr, float& fi) {
  const float dt = expf(p.in[9][l * 32 + g]);
  const float ar = p.in[3][(l * 32 + g) * 64 + n], ai = p.in[4][(l * 32 + g) * 64 + n];
  const float mag = expf(ar * dt), ang = ai * dt;
  float sn, cs;
  {
    float k = rintf(ang * 0.15915494309189535f);
    float rr = fmaf(-k, 6.28125f, ang);
    rr = fmaf(-k, 1.9353071795864769e-3f, rr);
    sn = sinf(rr);
    cs = cosf(rr);
  }
  abr = mag * cs;
  abi = mag * sn;
  const float den = ar * ar + ai * ai;
  fr = ((abr - 1.f) * ar + abi * ai) / den;
  fi = (abi * ar - (abr - 1.f) * ai) / den;
}

template <int MODE>
DEVI void s5_chunk_tasks(const Params& p, int l, char* smem) {
  char* ws = p.ws;
  const bf16_t* projb = (const bf16_t*)(ws + OFF_PROJ);
  float2* st = (float2*)(ws + OFF_S5ST);
  bf16_t* yg = (bf16_t*)(ws + OFF_YG);
  const int tid = tidx(), lane = tid & 63, w = tid >> 6;
  float* sU = (float*)smem + w * 1024;
  bf16_t* sH = (bf16_t*)(smem + 16384) + w * (16 * 136);
  const int ntask = NB * 32 * 128 / 4;
  for (int bt = blockIdx.x; bt < ntask; bt += gridDim.x) {
    const int task = bt * 4 + w;
    const int c = task & 127, g = (task >> 7) & 31, b = task >> 12;
    float abr, abi, fr, fi;
    s5_abar(p, l, g, lane, abr, abi, fr, fi);
    float bbr[16], bbi[16];
    {
      const float* br = p.in[5] + ((size_t)(l * 32 + g) * 64 + lane) * 16;
      const float* bi = p.in[6] + ((size_t)(l * 32 + g) * 64 + lane) * 16;
#pragma unroll
      for (int q = 0; q < 4; q++) {
        float4 x = *(const float4*)(br + 4 * q), y = *(const float4*)(bi + 4 * q);
        bbr[4 * q + 0] = fr * x.x - fi * y.x; bbi[4 * q + 0] = fr * y.x + fi * x.x;
        bbr[4 * q + 1] = fr * x.y - fi * y.y; bbi[4 * q + 1] = fr * y.y + fi * x.y;
        bbr[4 * q + 2] = fr * x.z - fi * y.z; bbi[4 * q + 2] = fr * y.z + fi * x.z;
        bbr[4 * q + 3] = fr * x.w - fi * y.w; bbi[4 * q + 3] = fr * y.w + fi * x.w;
      }
    }
    {
      const bf16_t* up = projb + (size_t)(b * SEQ + c * 64 + lane) * PJ + C_UA + g * 16;
      uint4 u0 = *(const uint4*)up, u1 = *(const uint4*)(up + 8);
      float f[16];
      unpack8(u0, f);
      unpack8(u1, f + 8);
#pragma unroll
      for (int q = 0; q < 4; q++) {
        float4 o = {f[4 * q], f[4 * q + 1], f[4 * q + 2], f[4 * q + 3]};
        *(float4*)(sU + lane * 16 + 4 * q) = o;
      }
    }
    const size_t sidx = ((size_t)(b * 32 + g) * 128 + c) * 64 + lane;
    float hr = 0.f, hi = 0.f;
    bf16x8 cf[4];
    if (MODE == 1) {
      float2 h0 = st[sidx];
      hr = h0.x; hi = h0.y;
      const int i = lane & 15, q4 = lane >> 4;
#pragma unroll
      for (int kq = 0; kq < 4; kq++) {
        const float* cp = (kq < 2 ? p.in[7] : p.in[8]) + ((size_t)(l * 32 + g) * 16 + i) * 64 + (kq & 1) * 32 + q4 * 8;
        float4 x = *(const float4*)cp, y = *(const float4*)(cp + 4);
        const float sg = kq < 2 ? 1.f : -1.f;
        bf16x8 v;
        v[0] = (short)f2bf(sg * x.x); v[1] = (short)f2bf(sg * x.y); v[2] = (short)f2bf(sg * x.z); v[3] = (short)f2bf(sg * x.w);
        v[4] = (short)f2bf(sg * y.x); v[5] = (short)f2bf(sg * y.y); v[6] = (short)f2bf(sg * y.z); v[7] = (short)f2bf(sg * y.w);
        cf[kq] = v;
      }
    }
    __syncthreads();
#pragma unroll 1
    for (int sub = 0; sub < 4; sub++) {
#pragma unroll 2
      for (int tt = 0; tt < 16; tt++) {
        const float* ur = sU + (sub * 16 + tt) * 16;
        float bur = 0.f, bui = 0.f;
#pragma unroll
        for (int q = 0; q < 4; q++) {
          float4 u = *(const float4*)(ur + 4 * q);
          bur = fmaf(u.x, bbr[4 * q], bur); bui = fmaf(u.x, bbi[4 * q], bui);
          bur = fmaf(u.y, bbr[4 * q + 1], bur); bui = fmaf(u.y, bbi[4 * q + 1], bui);
          bur = fmaf(u.z, bbr[4 * q + 2], bur); bui = fmaf(u.z, bbi[4 * q + 2], bui);
          bur = fmaf(u.w, bbr[4 * q + 3], bur); bui = fmaf(u.w, bbi[4 * q + 3], bui);
        }
        const float nr = abr * hr - abi * hi + bur;
        const float ni = abr * hi + abi * hr + bui;
        hr = nr; hi = ni;
        if (MODE == 1) {
          sH[tt * 136 + lane] = f2bf(hr);
          sH[tt * 136 + 64 + lane] = f2bf(hi);
        }
      }
      if (MODE == 1) {
        __syncthreads();
        const int i = lane & 15, q4 = lane >> 4;
        f32x4 acc = {0.f, 0.f, 0.f, 0.f};
#pragma unroll
        for (int kq = 0; kq < 4; kq++) acc = mfma16(cf[kq], ld8(sH + i * 136 + kq * 32 + q4 * 8), acc);
        const int t = sub * 16 + i;
        const float4 uu = *(const float4*)(sU + t * 16 + 4 * q4);
        const float4 dd = *(const float4*)(p.in[10] + l * 512 + g * 16 + 4 * q4);
        const float y0 = geluf(acc[0] + dd.x * uu.x), y1 = geluf(acc[1] + dd.y * uu.y);
        const float y2 = geluf(acc[2] + dd.z * uu.z), y3 = geluf(acc[3] + dd.w * uu.w);
        uint2 pk = {pack2(y0, y1), pack2(y2, y3)};
        *(uint2*)(yg + (size_t)(b * SEQ + c * 64 + t) * 512 + g * 16 + 4 * q4) = pk;
        __syncthreads();
      }
    }
    if (MODE == 0) {
      st[sidx] = make_float2(hr, hi);
    }
    __syncthreads();
  }
}

DEVI void s5_carry(const Params& p, int l, int idx) {
  float2* st = (float2*)(p.ws + OFF_S5ST);
  const int n = idx & 63, g = (idx >> 6) & 31, b = idx >> 11;
  float abr, abi, fr, fi;
  s5_abar(p, l, g, n, abr, abi, fr, fi);
  float pr = abr, pi = abi;
#pragma unroll
  for (int i = 0; i < 6; i++) {
    float nr = pr * pr - pi * pi, ni = 2.f * pr * pi;
    pr = nr; pi = ni;
  }
  float hr = 0.f, hi = 0.f;
  float2* s = st + ((size_t)(b * 32 + g) * 128) * 64 + n;
#pragma unroll 1
  for (int c0 = 0; c0 < 128; c0 += 16) {
    float2 e[16];
#pragma unroll
    for (int j = 0; j < 16; j++) e[j] = s[(size_t)(c0 + j) * 64];
#pragma unroll
    for (int j = 0; j < 16; j++) {
      s[(size_t)(c0 + j) * 64] = make_float2(hr, hi);
      const float nr = pr * hr - pi * hi + e[j].x;
      const float ni = pr * hi + pi * hr + e[j].y;
      hr = nr; hi = ni;
    }
  }
}

template <bool TRANSPOSED>
DEVI void conv_tile(const Params& p, int l, int b, int c, int h, int which, float scale, const float* rowscale, bf16_t* dst) {
  const bf16_t* projb = (const bf16_t*)(p.ws + OFF_PROJ);
  const int tid = tidx();
  const float* cw = p.in[13] + (size_t)l * 4 * 1024;
  const float* cb = p.in[14] + (size_t)l * 1024;
#pragma unroll
  for (int i = 0; i < 4; i++) {
    const int e = tid + 256 * i;
    const int tt = e >> 4, d8 = (e & 15) * 8;
    const int ch = which * 512 + h * 128 + d8;
    const int t = c * 64 + tt;
    float acc[8];
    {
      float4 b0 = *(const float4*)(cb + ch), b1 = *(const float4*)(cb + ch + 4);
      acc[0] = b0.x; acc[1] = b0.y; acc[2] = b0.z; acc[3] = b0.w;
      acc[4] = b1.x; acc[5] = b1.y; acc[6] = b1.z; acc[7] = b1.w;
    }
#pragma unroll
    for (int j = 0; j < 4; j++) {
      const int ts = t - 3 + j;
      if (ts >= 0) {
        uint4 xv = *(const uint4*)(projb + (size_t)(b * SEQ + ts) * PJ + C_QB + ch);
        float xf[8];
        unpack8(xv, xf);
        float4 w0 = *(const float4*)(cw + j * 1024 + ch), w1 = *(const float4*)(cw + j * 1024 + ch + 4);
        acc[0] = fmaf(w0.x, xf[0], acc[0]); acc[1] = fmaf(w0.y, xf[1], acc[1]);
        acc[2] = fmaf(w0.z, xf[2], acc[2]); acc[3] = fmaf(w0.w, xf[3], acc[3]);
        acc[4] = fmaf(w1.x, xf[4], acc[4]); acc[5] = fmaf(w1.y, xf[5], acc[5]);
        acc[6] = fmaf(w1.z, xf[6], acc[6]); acc[7] = fmaf(w1.w, xf[7], acc[7]);
      }
    }
    const float sc = rowscale ? scale * rowscale[tt] : scale;
#pragma unroll
    for (int q = 0; q < 8; q++) acc[q] = siluf(acc[q]) * sc;
    if (!TRANSPOSED) {
      uint4 o = {pack2(acc[0], acc[1]), pack2(acc[2], acc[3]), pack2(acc[4], acc[5]), pack2(acc[6], acc[7])};
      *(uint4*)(dst + tt * 136 + d8) = o;
    } else {
#pragma unroll
      for (int q = 0; q < 8; q++) dst[(d8 + q) * 72 + tt] = f2bf(acc[q]);
    }
  }
}
DEVI void vT_tile(const Params& p, int b, int c, int h, bf16_t* dst) {
  const bf16_t* projb = (const bf16_t*)(p.ws + OFF_PROJ);
  const int tid = tidx();
#pragma unroll
  for (int i = 0; i < 4; i++) {
    const int e = tid + 256 * i;
    const int tt = e >> 4, d8 = (e & 15) * 8;
    uint4 xv = *(const uint4*)(projb + (size_t)(b * SEQ + c * 64 + tt) * PJ + C_VB + h * 128 + d8);
    dst[(d8 + 0) * 72 + tt] = (bf16_t)(xv.x & 0xffffu);
    dst[(d8 + 1) * 72 + tt] = (bf16_t)(xv.x >> 16);
    dst[(d8 + 2) * 72 + tt] = (bf16_t)(xv.y & 0xffffu);
    dst[(d8 + 3) * 72 + tt] = (bf16_t)(xv.y >> 16);
    dst[(d8 + 4) * 72 + tt] = (bf16_t)(xv.z & 0xffffu);
    dst[(d8 + 5) * 72 + tt] = (bf16_t)(xv.z >> 16);
    dst[(d8 + 6) * 72 + tt] = (bf16_t)(xv.w & 0xffffu);
    dst[(d8 + 7) * 72 + tt] = (bf16_t)(xv.w >> 16);
  }
}
DEVI float logsigf(float x) { return fminf(x, 0.f) - log1pf(expf(-fabsf(x))); }

DEVI void mlstm_local(const Params& p, int l, int task, char* smem) {
  char* ws = p.ws;
  const int tid = tidx(), lane = tid & 63, w = tid >> 6;
  const int c = task & 127, h = (task >> 7) & 3, b = task >> 9;
  const int bh = b * 4 + h;
  bf16_t* sKT = (bf16_t*)smem;
  bf16_t* sVT = sKT + 128 * 72;
  float* sW = (float*)(smem + 2 * 128 * 72 * 2);
  const float* small = (const float*)(ws + OFF_SMALL);
  float* msc = (float*)(ws + OFF_MSC);
  __syncthreads();
  if (w == 0) {
    const size_t row = (size_t)(b * SEQ + c * 64 + lane) * 16;
    const float ipre = small[row + h] + p.in[15][l * 4 + h];
    const float lf = logsigf(small[row + 4 + h] + p.in[16][l * 4 + h]);
    float bc = lf;
#pragma unroll
    for (int o = 1; o < 64; o <<= 1) {
      float v = __shfl_up(bc, o, 64);
      if (lane >= o) bc += v;
    }
    const float blast = __shfl(bc, 63, 64);
    const float ge = blast - bc + ipre;
    float mx = ge;
#pragma unroll
    for (int o = 32; o > 0; o >>= 1) mx = fmaxf(mx, __shfl_xor(mx, o, 64));
    sW[lane] = expf(ge - mx);
    if (lane == 0) {
      msc[bh * 128 + c] = mx;
      msc[1024 + bh * 128 + c] = blast;
    }
  }
  __syncthreads();
  conv_tile<true>(p, l, b, c, h, 1, 0.08838834764831845f, sW, sKT);
  vT_tile(p, b, c, h, sVT);
  __syncthreads();
  if (tid < 128) {
    float s = 0.f;
    for (int t = 0; t < 64; t++) s += bf2f(sKT[tid * 72 + t]);
    ((float*)(ws + OFF_MN))[((size_t)bh * 128 + c) * 128 + tid] = s;
  }
  const int r = lane & 31, hh = lane >> 5;
  f32x16 acc[4];
#pragma unroll
  for (int ci = 0; ci < 4; ci++)
#pragma unroll
    for (int i = 0; i < 16; i++) acc[ci][i] = 0.f;
#pragma unroll
  for (int ks = 0; ks < 4; ks++) {
    bf16x8 a = ld8(sVT + (32 * w + r) * 72 + ks * 16 + hh * 8);
#pragma unroll
    for (int ci = 0; ci < 4; ci++) acc[ci] = mfma32(a, ld8(sKT + (32 * ci + r) * 72 + ks * 16 + hh * 8), acc[ci]);
  }
  bf16_t* CT = (bf16_t*)(ws + OFF_MCT) + ((size_t)bh * 128 + c) * 16384;
#pragma unroll
  for (int ci = 0; ci < 4; ci++)
#pragma unroll
    for (int i = 0; i < 16; i++) {
      const int dv = 32 * w + (i & 3) + 8 * (i >> 2) + 4 * hh;
      CT[dv * 128 + 32 * ci + r] = f2bf(acc[ci][i]);
    }
}

DEVI void mlstm_carry(const Params& p, int task, char* smem) {
  char* ws = p.ws;
  const int tid = tidx();
  float* msc = (float*)(ws + OFF_MSC);
  float* sDecay = (float*)smem;
  float* sScale = sDecay + 128;
  const int bh = task / 9, seg = task % 9;
  float* sMl = sScale + 128;
  float* sBl = sMl + 128;
  __syncthreads();
  if (tid < 128) { sMl[tid] = msc[bh * 128 + tid]; sBl[tid] = msc[1024 + bh * 128 + tid]; }
  __syncthreads();
  if (tid == 0) {
    float mprev = 0.f;
    for (int c = 0; c < 128; c++) {
      const float mloc = sMl[c], blast = sBl[c];
      const float mnext = fmaxf(blast + mprev, mloc);
      sDecay[c] = expf(blast + mprev - mnext);
      sScale[c] = expf(mloc - mnext);
      sMl[c] = mprev;
      mprev = mnext;
    }
  }
  __syncthreads();
  if (seg == 0 && tid < 128) msc[2048 + bh * 128 + tid] = sMl[tid];
  if (seg < 8) {
    bf16_t* CT = (bf16_t*)(ws + OFF_MCT) + (size_t)bh * 128 * 16384 + (size_t)(seg * 256 + tid) * 8;
    float cs[8];
#pragma unroll
    for (int q = 0; q < 8; q++) cs[q] = 0.f;
#pragma unroll 1
    for (int c0 = 0; c0 < 128; c0 += 16) {
      u32x4 v[16];
#pragma unroll
      for (int j = 0; j < 16; j++) v[j] = *(const u32x4*)(CT + (size_t)(c0 + j) * 16384);
#pragma unroll
      for (int j = 0; j < 16; j++) {
        u32x4 o = {pack2(cs[0], cs[1]), pack2(cs[2], cs[3]), pack2(cs[4], cs[5]), pack2(cs[6], cs[7])};
        *(u32x4*)(CT + (size_t)(c0 + j) * 16384) = o;
        const float dc = sDecay[c0 + j], sc = sScale[c0 + j];
        cs[0] = dc * cs[0] + sc * lo2f(v[j][0]); cs[1] = dc * cs[1] + sc * hi2f(v[j][0]);
        cs[2] = dc * cs[2] + sc * lo2f(v[j][1]); cs[3] = dc * cs[3] + sc * hi2f(v[j][1]);
        cs[4] = dc * cs[4] + sc * lo2f(v[j][2]); cs[5] = dc * cs[5] + sc * hi2f(v[j][2]);
        cs[6] = dc * cs[6] + sc * lo2f(v[j][3]); cs[7] = dc * cs[7] + sc * hi2f(v[j][3]);
      }
    }
  } else if (tid < 128) {
    float* N = (float*)(ws + OFF_MN) + (size_t)bh * 128 * 128 + tid;
    float ns = 0.f;
#pragma unroll 1
    for (int c0 = 0; c0 < 128; c0 += 16) {
      float v[16];
#pragma unroll
      for (int j = 0; j < 16; j++) v[j] = N[(size_t)(c0 + j) * 128];
#pragma unroll
      for (int j = 0; j < 16; j++) {
        N[(size_t)(c0 + j) * 128] = ns;
        ns = sDecay[c0 + j] * ns + sScale[c0 + j] * v[j];
      }
    }
  }
}

DEVI void mlstm_out(const Params& p, int l, int task, char* smem) {
  char* ws = p.ws;
  const int tid = tidx(), lane = tid & 63, w = tid >> 6;
  const int c = task & 127, h = (task >> 7) & 3, b = task >> 9;
  const int bh = b * 4 + h;
  bf16_t* sQ = (bf16_t*)smem;
  bf16_t* sK = sQ + 64 * 136;
  bf16_t* sVT = sK + 64 * 136;
  float* sA = (float*)(smem + (2 * 64 * 136 + 128 * 72) * 2);
  float* sM = sA + 64;
  float* sBc = sM + 64;
  float* sN = sBc + 64;
  float* sPart = sN + 128;
  const float* small = (const float*)(ws + OFF_SMALL);
  const float* msc = (const float*)(ws + OFF_MSC);
  const float mprev = msc[2048 + bh * 128 + c];
  __syncthreads();
  if (w == 0) {
    const size_t row = (size_t)(b * SEQ + c * 64 + lane) * 16;
    const float ipre = small[row + h] + p.in[15][l * 4 + h];
    const float lf = logsigf(small[row + 4 + h] + p.in[16][l * 4 + h]);
    float bc = lf;
#pragma unroll
    for (int o = 1; o < 64; o <<= 1) {
      float v = __shfl_up(bc, o, 64);
      if (lane >= o) bc += v;
    }
    const float a = ipre - bc;
    float pm = a;
#pragma unroll
    for (int o = 1; o < 64; o <<= 1) {
      float v = __shfl_up(pm, o, 64);
      if (lane >= o) pm = fmaxf(pm, v);
    }
    sA[lane] = a;
    sM[lane] = fmaxf(mprev, pm);
    sBc[lane] = bc;
  }
  if (tid >= 128) sN[tid - 128] = ((const float*)(ws + OFF_MN))[((size_t)bh * 128 + c) * 128 + (tid - 128)];
  conv_tile<false>(p, l, b, c, h, 0, 1.f, nullptr, sQ);
  conv_tile<false>(p, l, b, c, h, 1, 0.08838834764831845f, nullptr, sK);
  vT_tile(p, b, c, h, sVT);
  __syncthreads();
  const int r = lane & 31, hh = lane >> 5;
  const int tt = w & 1, eh = w >> 1;
  const int tl = 32 * tt + r;
  const float Mt = sM[tl], bct = sBc[tl];
  const float mt = bct + Mt;
  const float interw = expf(mprev - Mt);
  float qn = 0.f;
  for (int d = 0; d < 64; d++) qn = fmaf(bf2f(sQ[tl * 136 + hh * 64 + d]), sN[hh * 64 + d], qn);
  qn += shx32(qn);
  f32x16 oacc[2];
#pragma unroll
  for (int ei = 0; ei < 2; ei++)
#pragma unroll
    for (int i = 0; i < 16; i++) oacc[ei][i] = 0.f;
  float den = 0.f;
  for (int si = 0; si <= tt; si++) {
    f32x16 sacc;
#pragma unroll
    for (int i = 0; i < 16; i++) sacc[i] = 0.f;
#pragma unroll
    for (int ks = 0; ks < 8; ks++)
      sacc = mfma32(ld8(sK + (32 * si + r) * 136 + ks * 16 + hh * 8), ld8(sQ + tl * 136 + ks * 16 + hh * 8), sacc);
    float pv[16];
#pragma unroll
    for (int i = 0; i < 16; i++) {
      const int s = 32 * si + (i & 3) + 8 * (i >> 2) + 4 * hh;
      const float v = (s <= tl) ? sacc[i] * expf(sA[s] - Mt) : 0.f;
      pv[i] = v;
      den += v;
    }
#pragma unroll
    for (int k2 = 0; k2 < 2; k2++) {
      bf16x8 pf;
#pragma unroll
      for (int j = 0; j < 8; j++) pf[j] = (short)f2bf(pv[8 * k2 + j]);
#pragma unroll
      for (int ei = 0; ei < 2; ei++) {
        const bf16_t* vp = sVT + (eh * 64 + ei * 32 + r) * 72 + 32 * si + 16 * k2 + 4 * hh;
        uint2 lo = *(const uint2*)vp, hi = *(const uint2*)(vp + 8);
        uint4 av = {lo.x, lo.y, hi.x, hi.y};
        oacc[ei] = mfma32(*(bf16x8*)&av, pf, oacc[ei]);
      }
    }
  }
  den += shx32(den);
  den += interw * qn;
  const bf16_t* CT = (const bf16_t*)(ws + OFF_MCT) + ((size_t)bh * 128 + c) * 16384;
  f32x16 cacc[2];
#pragma unroll
  for (int ei = 0; ei < 2; ei++)
#pragma unroll
    for (int i = 0; i < 16; i++) cacc[ei][i] = 0.f;
#pragma unroll
  for (int ks = 0; ks < 8; ks++) {
    bf16x8 qf = ld8(sQ + tl * 136 + ks * 16 + hh * 8);
#pragma unroll
    for (int ei = 0; ei < 2; ei++)
      cacc[ei] = mfma32(ld8(CT + (size_t)(eh * 64 + ei * 32 + r) * 128 + ks * 16 + hh * 8), qf, cacc[ei]);
  }
  const float dinv = 1.f / fmaxf(fabsf(den), expf(-mt));
  float ssq = 0.f;
#pragma unroll
  for (int ei = 0; ei < 2; ei++)
#pragma unroll
    for (int i = 0; i < 16; i++) {
      const float hv = (oacc[ei][i] + interw * cacc[ei][i]) * dinv;
      oacc[ei][i] = hv;
      ssq += hv * hv;
    }
  ssq += shx32(ssq);
  if (hh == 0) sPart[eh * 64 + tl] = ssq;
  __syncthreads();
  const float rs = rsqrtf((sPart[tl] + sPart[64 + tl]) * (1.f / 128.f) + EPS);
  const bf16_t* projb = (const bf16_t*)(ws + OFF_PROJ);
  bf16_t* ys = (bf16_t*)(ws + OFF_YS) + (size_t)1 * T * 512;
  const size_t tok = (size_t)(b * SEQ + c * 64 + tl);
#pragma unroll
  for (int ei = 0; ei < 2; ei++)
#pragma unroll
    for (int g = 0; g < 4; g++) {
      const int e = eh * 64 + ei * 32 + 8 * g + 4 * hh;
      const float4 gg = *(const float4*)(p.in[17] + l * 512 + h * 128 + e);
      const uint2 zz = *(const uint2*)(projb + tok * PJ + C_ZB + h * 128 + e);
      const float o0 = oacc[ei][4 * g] * rs * gg.x * siluf(lo2f(zz.x));
      const float o1 = oacc[ei][4 * g + 1] * rs * gg.y * siluf(hi2f(zz.x));
      const float o2 = oacc[ei][4 * g + 2] * rs * gg.z * siluf(lo2f(zz.y));
      const float o3 = oacc[ei][4 * g + 3] * rs * gg.w * siluf(hi2f(zz.y));
      uint2 pk = {pack2(o0, o1), pack2(o2, o3)};
      *(uint2*)(ys + tok * 512 + h * 128 + e) = pk;
    }
}

DEVI void qq_tile(const Params& p, int l, int id, char* smem) {
  char* ws = p.ws;
  const bf16_t* projb = (const bf16_t*)(ws + OFF_PROJ);
  const bf16_t* W = (const bf16_t*)(ws + OFF_WQ) + (size_t)l * 1024 * 256;
  bf16_t* qq = (bf16_t*)(ws + OFF_QQ);
  float* rsc = (float*)(smem + 2 * 128 * GLD * 2);
  const int mt = id >> 3, nt = id & 7;
  const int m0 = mt * 128, n0 = nt * 128;
  const int tid = tidx();
  __syncthreads();
  {
    const int row = tid >> 1, half = tid & 1;
    const bf16_t* cp = projb + (size_t)(m0 + row) * PJ + C_CQ + half * 128;
    float ss = 0.f;
#pragma unroll
    for (int i = 0; i < 16; i++) {
      uint4 v = *(const uint4*)(cp + i * 8);
      float f[8];
      unpack8(v, f);
#pragma unroll
      for (int q = 0; q < 8; q++) ss = fmaf(f[q], f[q], ss);
    }
    ss += __shfl_xor(ss, 1, 64);
    if (half == 0) rsc[row] = rsqrtf(ss * (1.f / 256.f) + EPS);
  }
  f32x16 acc[2][2];
  zero_acc<2>(acc);
  gemm_mainloop<2>(projb + (size_t)m0 * PJ + C_CQ, PJ, W + (size_t)n0 * 256, 256, 256, smem, acc);
  {
    bf16_t* sT = (bf16_t*)smem;
    __syncthreads();
    gemm_epilogue<2>(acc, [&](int ml, int nl, f32x4 v) {
      const float rs = rsc[ml];
      uint2 pk = {pack2(v[0] * rs, v[1] * rs), pack2(v[2] * rs, v[3] * rs)};
      *(uint2*)(sT + ml * 136 + nl) = pk;
    });
    __syncthreads();
#pragma unroll
    for (int j = 0; j < 8; j++) {
      const int c = tid + 256 * j;
      const int row = c >> 4, col = (c & 15) * 8;
      *(uint4*)(qq + (size_t)(m0 + row) * 1024 + n0 + col) = *(const uint4*)(sT + row * 136 + col);
    }
  }
}
DEVI void kiv_task(const Params& p, int l, int id, char* smem) {
  char* ws = p.ws;
  const bf16_t* projb = (const bf16_t*)(ws + OFF_PROJ);
  bf16_t* ki = (bf16_t*)(ws + OFF_KI);
  bf16_t* vT = (bf16_t*)(ws + OFF_VT);
  bf16_t* sT = (bf16_t*)smem;
  const int tid = tidx();
  const int tok0 = id * 64;
  const int b = tok0 / SEQ, s0 = tok0 % SEQ;
  __syncthreads();
  {
    const int tk = tid >> 2, qd = tid & 3;
    const bf16_t* kp = projb + (size_t)(tok0 + tk) * PJ + C_KIDX + qd * 16;
    float f[16];
    unpack8(*(const uint4*)kp, f);
    unpack8(*(const uint4*)(kp + 8), f + 8);
    float mu = 0.f;
#pragma unroll
    for (int i = 0; i < 16; i++) mu += f[i];
    mu += __shfl_xor(mu, 1, 64);
    mu += __shfl_xor(mu, 2, 64);
    mu *= (1.f / 64.f);
    float var = 0.f;
#pragma unroll
    for (int i = 0; i < 16; i++) { f[i] -= mu; var = fmaf(f[i], f[i], var); }
    var += __shfl_xor(var, 1, 64);
    var += __shfl_xor(var, 2, 64);
    const float rs = rsqrtf(var * (1.f / 64.f) + EPS);
    const float* g = p.in[21] + l * 64 + qd * 16;
    const float* bb = p.in[22] + l * 64 + qd * 16;
    float o[16];
#pragma unroll
    for (int i = 0; i < 16; i++) o[i] = f[i] * rs * g[i] + bb[i];
    uint4 o0 = {pack2(o[0], o[1]), pack2(o[2], o[3]), pack2(o[4], o[5]), pack2(o[6], o[7])};
    uint4 o1 = {pack2(o[8], o[9]), pack2(o[10], o[11]), pack2(o[12], o[13]), pack2(o[14], o[15])};
    *(uint4*)(ki + (size_t)(tok0 + tk) * 64 + qd * 16) = o0;
    *(uint4*)(ki + (size_t)(tok0 + tk) * 64 + qd * 16 + 8) = o1;
  }
  {
    const int tk = tid >> 2, part = tid & 3;
    const bf16_t* kp = projb + (size_t)(tok0 + tk) * PJ + C_KC + part * 32;
    float ss = 0.f;
#pragma unroll
    for (int k = 0; k < 4; k++) {
      float f[8];
      unpack8(*(const uint4*)(kp + 8 * k), f);
#pragma unroll
      for (int q = 0; q < 8; q++) ss = fmaf(f[q], f[q], ss);
    }
#pragma unroll
    for (int o = 1; o < 64; o <<= 1) ss = (o < 4) ? ss + __shfl_xor(ss, o, 64) : fmaxf(ss, __shfl_xor(ss, o, 64));
    if ((tid & 63) == 0) atomicMax((unsigned*)(ws + OFF_KMAX) + l * 2 + b, __float_as_uint(ss));
  }
#pragma unroll
  for (int i = 0; i < 4; i++) {
    const int e = tid + 256 * i;
    const int tt = e >> 4, d8 = (e & 15) * 8;
    uint4 xv = *(const uint4*)(projb + (size_t)(tok0 + tt) * PJ + C_VC + d8);
    sT[(d8 + 0) * 72 + tt] = (bf16_t)(xv.x & 0xffffu);
    sT[(d8 + 1) * 72 + tt] = (bf16_t)(xv.x >> 16);
    sT[(d8 + 2) * 72 + tt] = (bf16_t)(xv.y & 0xffffu);
    sT[(d8 + 3) * 72 + tt] = (bf16_t)(xv.y >> 16);
    sT[(d8 + 4) * 72 + tt] = (bf16_t)(xv.z & 0xffffu);
    sT[(d8 + 5) * 72 + tt] = (bf16_t)(xv.z >> 16);
    sT[(d8 + 6) * 72 + tt] = (bf16_t)(xv.w & 0xffffu);
    sT[(d8 + 7) * 72 + tt] = (bf16_t)(xv.w >> 16);
  }
  __syncthreads();
#pragma unroll
  for (int i = 0; i < 4; i++) {
    const int e = tid + 256 * i;
    const int d = e >> 3, c8 = (e & 7) * 8;
    *(uint4*)(vT + ((size_t)b * 128 + d) * SEQ + s0 + c8) = *(const uint4*)(sT + d * 72 + c8);
  }
}

constexpr int QLD = 584;
DEVI void load_kf(bf16x8 (&kf)[4], const bf16_t* __restrict__ kib, int s0, int i, int q4) {
#pragma unroll
  for (int kt = 0; kt < 2; kt++)
#pragma unroll
    for (int kq = 0; kq < 2; kq++) kf[kt * 2 + kq] = ld8(kib + (size_t)(s0 + 16 * kt + i) * 64 + 32 * kq + 8 * q4);
}
DEVI void score_tile(const bf16x8 (&kf)[4], const bf16x8 (&qr)[18], const float (&wh)[8], f32x4& sc0, f32x4& sc1) {
  sc0 = {0.f, 0.f, 0.f, 0.f};
  sc1 = {0.f, 0.f, 0.f, 0.f};
  sc0 = mfma16(kf[0], qr[16], sc0);
  sc0 = mfma16(kf[1], qr[17], sc0);
  sc1 = mfma16(kf[2], qr[16], sc1);
  sc1 = mfma16(kf[3], qr[17], sc1);
#pragma unroll
  for (int h = 0; h < 8; h++) {
    f32x4 d0 = {0.f, 0.f, 0.f, 0.f}, d1 = {0.f, 0.f, 0.f, 0.f};
    d0 = mfma16(kf[0], qr[2 * h], d0);
    d0 = mfma16(kf[1], qr[2 * h + 1], d0);
    d1 = mfma16(kf[2], qr[2 * h], d1);
    d1 = mfma16(kf[3], qr[2 * h + 1], d1);
#pragma unroll
    for (int rg = 0; rg < 4; rg++) {
      sc0[rg] = fmaf(fabsf(d0[rg]), wh[h], sc0[rg]);
      sc1[rg] = fmaf(fabsf(d1[rg]), wh[h], sc1[rg]);
    }
  }
}
DEVI unsigned monokey(float f) {
  unsigned u = __float_as_uint(f);
  return (u & 0x80000000u) ? ~u : (u | 0x80000000u);
}

constexpr int DSA_OFF_STAGE = 16 * QLD * 2;
constexpr int KLD = 136, VLD = 72;
constexpr int DSA_STAGE_BYTES = 64 * KLD * 2 + 128 * VLD * 2;
constexpr int DSA_OFF_HIST = DSA_OFF_STAGE;
constexpr int DSA_OFF_CODE = DSA_OFF_HIST + 16 * 129 * 4;
constexpr int DSA_OFF_SEGS = DSA_OFF_CODE + 16 * 129 * 4;
constexpr int DSA_OFF_MASKA = DSA_OFF_STAGE + 18048;
static_assert(DSA_OFF_SEGS + 176 * 4 <= DSA_OFF_MASKA, "layout");
static_assert(DSA_OFF_MASKA + 16384 <= DSA_OFF_STAGE + DSA_STAGE_BYTES, "layout");
constexpr int DSA_OFF_WQ = DSA_OFF_STAGE + DSA_STAGE_BYTES;
constexpr int DSA_OFF_MISC = DSA_OFF_WQ + 512;
static_assert(DSA_OFF_MISC + 256 <= SMEM_BYTES, "LDS overflow");
constexpr int QB = 16;

DEVI void dsa_task(const Params& p, int l, int b, int t0, char* smem) {
  char* ws = p.ws;
  bf16_t* sQI = (bf16_t*)smem;
  unsigned char* maskF = (unsigned char*)smem;
  unsigned* hist = (unsigned*)(smem + DSA_OFF_HIST);
  unsigned* code = (unsigned*)(smem + DSA_OFF_CODE);
  unsigned* segs = (unsigned*)(smem + DSA_OFF_SEGS);
  unsigned* pref = segs + 128;
  int* krem = (int*)(pref + 16);
  unsigned* thr = (unsigned*)(krem + 16);
  unsigned char* maskA = (unsigned char*)(smem + DSA_OFF_MASKA);
  unsigned* maskAw = (unsigned*)(smem + DSA_OFF_MASKA);
  bf16_t* sK = (bf16_t*)(smem + DSA_OFF_STAGE);
  bf16_t* sVT = sK + 64 * KLD;
  float* sWq = (float*)(smem + DSA_OFF_WQ);
  int* cnt = (int*)(smem + DSA_OFF_MISC);
  int* ovf = cnt + 32;
  const int tid = tidx(), lane = tid & 63, w = tid >> 6;
  const int i = lane & 15, q4 = lane >> 4;
  const bf16_t* qq = (const bf16_t*)(ws + OFF_QQ);
  const bf16_t* projb = (const bf16_t*)(ws + OFF_PROJ);
  const bf16_t* kib = (const bf16_t*)(ws + OFF_KI) + (size_t)b * SEQ * 64;
  const bf16_t* vT = (const bf16_t*)(ws + OFF_VT) + (size_t)b * 128 * SEQ;
  const float* small = (const float*)(ws + OFF_SMALL);
  const int n_it = (t0 + QB + 127) >> 7;
  const int tq = t0 + i;
  const int tlast = t0 + QB - 1;
  const bool need_sel = (tlast > 255);
  __syncthreads();
  if (tid < 16) { thr[tid] = 0u; pref[tid] = 0u; krem[tid] = 256; cnt[tid] = 0; }
  if (tid == 0) *ovf = 0;
  for (int k = tid; k < 16 * 129; k += 256) hist[k] = 0u;
  {
    uint4 z = {0u, 0u, 0u, 0u};
#pragma unroll
    for (int k = 0; k < 4; k++) *(uint4*)(maskA + (tid * 4 + k) * 16) = z;
  }
  __syncthreads();
  if (need_sel) {
    bf16x8 qr[18];
    float wh[8];
    {
      const bf16_t* qrow = qq + (size_t)(b * SEQ + t0 + i) * 1024 + 512 + 8 * q4;
#pragma unroll
      for (int h = 0; h < 8; h++) { qr[2 * h] = ld8(qrow + h * 64); qr[2 * h + 1] = ld8(qrow + h * 64 + 32); }
      const float4 w0 = *(const float4*)(small + (size_t)(b * SEQ + t0 + i) * 16 + 8);
      const float4 w1 = *(const float4*)(small + (size_t)(b * SEQ + t0 + i) * 16 + 12);
      const float sc = 0.5f * 0.044194173824159216f;
      wh[0] = w0.x * sc; wh[1] = w0.y * sc; wh[2] = w0.z * sc; wh[3] = w0.w * sc;
      wh[4] = w1.x * sc; wh[5] = w1.y * sc; wh[6] = w1.z * sc; wh[7] = w1.w * sc;
#pragma unroll
      for (int kq = 0; kq < 2; kq++) {
        float a[8];
#pragma unroll
        for (int j = 0; j < 8; j++) a[j] = 0.f;
#pragma unroll
        for (int h = 0; h < 8; h++) {
#pragma unroll
          for (int j = 0; j < 8; j++) a[j] = fmaf(wh[h], bf2f((bf16_t)qr[2 * h + kq][j]), a[j]);
        }
        bf16x8 o;
#pragma unroll
        for (int j = 0; j < 8; j++) o[j] = (short)f2bf(a[j]);
        qr[16 + kq] = o;
      }
    }
#pragma unroll 1
    for (int pass = 0; pass < 5; pass++) {
      const int shift = 24 - 8 * pass;
      const unsigned pf = pref[i];
      const bool collect = (pass == 2) && (*ovf == 0);
      const bool maskthr = (pass == 4);
      const unsigned thr_i = thr[i];
      bf16x8 kf[4], kn[4], kn2[4];
      load_kf(kf, kib, w * 32, i, q4);
      if (w * 32 + 128 <= tlast) load_kf(kn, kib, w * 32 + 128, i, q4);
#pragma unroll 1
      for (int it = 0; it < n_it; it++) {
        const int s0 = it * 128 + w * 32;
        const bool valid = (s0 <= tlast);
        if (s0 + 256 <= tlast) load_kf(kn2, kib, s0 + 256, i, q4);
        if (valid) {
          f32x4 sc0, sc1;
          score_tile(kf, qr, wh, sc0, sc1);
          unsigned bits = 0u;
#pragma unroll
          for (int e = 0; e < 8; e++) {
            const int s = s0 + 16 * (e >> 2) + 4 * q4 + (e & 3);
            const unsigned key = monokey((e < 4) ? sc0[e & 3] : sc1[e & 3]);
            if (s <= tq) {
              if (collect) {
                const unsigned k16 = key >> 16;
                if (k16 > pf) bits |= (1u << e);
                else if (k16 == pf) {
                  const int idx = atomicAdd(&cnt[i], 1);
                  if (idx < 128) { hist[i * 129 + idx] = key; code[i * 129 + idx] = ((unsigned)((it * 4 + w) * 64 + lane) << 3) | (unsigned)e; }
                }
              } else if (maskthr) {
                if (key >= thr_i) bits |= (1u << e);
              } else if (pass == 0 || ((key >> (shift + 8)) == pf)) {
                const unsigned bin = (key >> shift) & 255u;
                atomicAdd(&hist[i * 129 + (bin >> 1)], 1u << ((bin & 1u) * 16));
              }
            }
          }
          if (collect || maskthr) maskA[(it * 4 + w) * 64 + lane] = (unsigned char)bits;
        }
#pragma unroll
        for (int ks = 0; ks < 4; ks++) { kf[ks] = kn[ks]; kn[ks] = kn2[ks]; }
      }
      __syncthreads();
      if (maskthr) break;
      if (collect) {
        if (tid < 128) {
          const int q = tid >> 3, j = tid & 7;
          const int nraw = cnt[q];
          const int n = nraw < 128 ? nraw : 128;
          const int kr = krem[q];
          if (nraw > 128) *ovf = 1;
          for (int e = j; e < n; e += 8) {
            const unsigned ke = hist[q * 129 + e];
            int g = 0, ge = 0;
            for (int f = 0; f < n; f++) {
              const unsigned kf2 = hist[q * 129 + f];
              g += (kf2 > ke) ? 1 : 0;
              ge += (kf2 >= ke) ? 1 : 0;
            }
            if (g < kr && ge >= kr) thr[q] = ke;
          }
        }
        __syncthreads();
        if (*ovf == 0) {
          if (tid < 128) {
            const int q = tid >> 3, j = tid & 7;
            const int n = cnt[q];
            const unsigned tq2 = thr[q];
            for (int e = j; e < n; e += 8) {
              if (hist[q * 129 + e] >= tq2) {
                const unsigned cd = code[q * 129 + e];
                const unsigned byte = cd >> 3, bit = cd & 7u;
                atomicOr(&maskAw[byte >> 2], 1u << ((byte & 3u) * 8 + bit));
              }
            }
          }
          __syncthreads();
          break;
        }
        for (int k = tid; k < 16 * 129; k += 256) hist[k] = 0u;
        __syncthreads();
        pass--;
        continue;
      }
      if (tid < 128) {
        const int q = tid >> 3, j = tid & 7;
        unsigned ssum = 0;
#pragma unroll
        for (int k = 0; k < 16; k++) {
          const unsigned wv = hist[q * 129 + 16 * j + k];
          ssum += (wv & 0xffffu) + (wv >> 16);
        }
        segs[q * 8 + j] = ssum;
      }
      __syncthreads();
      if (tid < 16) {
        const int q = tid;
        const int kr = krem[q];
        int cum = 0, j = 7;
        while (j > 0 && cum + (int)segs[q * 8 + j] < kr) { cum += (int)segs[q * 8 + j]; j--; }
        int bin = 32 * j + 31;
        while (bin > 32 * j) {
          const unsigned wv = hist[q * 129 + (bin >> 1)];
          const int c2 = (bin & 1) ? (int)(wv >> 16) : (int)(wv & 0xffffu);
          if (cum + c2 >= kr) break;
          cum += c2;
          bin--;
        }
        pref[q] = (pref[q] << 8) | (unsigned)bin;
        krem[q] = kr - cum;
        if (pass == 3) thr[q] = pref[q];
      }
      __syncthreads();
      for (int k = tid; k < 16 * 129; k += 256) hist[k] = 0u;
      __syncthreads();
    }
  } else {
    for (int it = 0; it < n_it; it++) {
      const int s0 = it * 128 + w * 32;
      unsigned bits = 0u;
#pragma unroll
      for (int e = 0; e < 8; e++) {
        const int s = s0 + 16 * (e >> 2) + 4 * q4 + (e & 3);
        if (s <= tq) bits |= (1u << e);
      }
      maskA[(it * 4 + w) * 64 + lane] = (unsigned char)bits;
    }
    __syncthreads();
  }
  {
    uint4 mv[4];
#pragma unroll
    for (int k = 0; k < 4; k++) mv[k] = *(const uint4*)(maskA + (tid * 4 + k) * 16);
#pragma unroll
    for (int k = 0; k < 4; k++) *(uint4*)(maskF + (tid * 4 + k) * 16) = mv[k];
  }
  __syncthreads();
  const int hp = w >> 1, hf = w & 1;
  bf16x8 qf[2][4];
#pragma unroll
  for (int hd = 0; hd < 2; hd++)
#pragma unroll
    for (int kq = 0; kq < 4; kq++)
      qf[hd][kq] = ld8(qq + (size_t)(b * SEQ + t0 + i) * 1024 + (2 * hp + hd) * 128 + 32 * kq + 8 * q4);
  f32x4 O[2][8];
#pragma unroll
  for (int hd = 0; hd < 2; hd++)
#pragma unroll
    for (int dt = 0; dt < 8; dt++) O[hd][dt] = {0.f, 0.f, 0.f, 0.f};
  float l_run[2] = {0.f, 0.f};
  const float scale = 0.08838834764831845f;
  float m_ref[2];
  {
    const float kmax2 = __uint_as_float(__hip_atomic_load((const unsigned*)(ws + OFF_KMAX) + l * 2 + b, __ATOMIC_RELAXED, __HIP_MEMORY_SCOPE_AGENT));
#pragma unroll
    for (int hd = 0; hd < 2; hd++) {
      float qn = 0.f;
#pragma unroll
      for (int kq = 0; kq < 4; kq++)
#pragma unroll
        for (int j = 0; j < 8; j++) { const float v = bf2f((bf16_t)qf[hd][kq][j]); qn = fmaf(v, v, qn); }
      qn += __shfl_xor(qn, 16, 64);
      qn += __shfl_xor(qn, 32, 64);
      m_ref[hd] = fminf(sqrtf(qn * kmax2) * scale, 40.f);
    }
  }
  const int krow = tid >> 2, kcol = (tid & 3) * 32;
  const int vrow = tid >> 1, vcol = (tid & 1) * 32;
  const bf16_t* kg = projb + (size_t)(b * SEQ + krow) * PJ + C_KC + kcol;
  const bf16_t* vg = vT + (size_t)vrow * SEQ + vcol;
  u32x4 pk[4], pvr[4];
#pragma unroll
  for (int k = 0; k < 4; k++) { pk[k] = *(const u32x4*)(kg + 8 * k); pvr[k] = *(const u32x4*)(vg + 8 * k); }
#pragma unroll 1
  for (int ss0 = 0; ss0 <= tlast; ss0 += 64) {
    __syncthreads();
#pragma unroll
    for (int k = 0; k < 4; k++) {
      *(u32x4*)(sK + krow * KLD + kcol + 8 * k) = pk[k];
      *(u32x4*)(sVT + vrow * VLD + vcol + 8 * k) = pvr[k];
    }
    __syncthreads();
    if (ss0 + 64 <= tlast) {
      const bf16_t* kg2 = kg + (size_t)(ss0 + 64) * PJ;
      const bf16_t* vg2 = vg + ss0 + 64;
#pragma unroll
      for (int k = 0; k < 4; k++) { pk[k] = *(const u32x4*)(kg2 + 8 * k); pvr[k] = *(const u32x4*)(vg2 + 8 * k); }
    }
    const unsigned mb = (unsigned)maskF[((ss0 >> 5) + hf) * 64 + lane];
    if (__ballot(mb != 0u) == 0ull) continue;
    f32x4 sa[2][2];
#pragma unroll
    for (int hd = 0; hd < 2; hd++)
#pragma unroll
      for (int kt = 0; kt < 2; kt++) sa[hd][kt] = {0.f, 0.f, 0.f, 0.f};
#pragma unroll
    for (int kq = 0; kq < 4; kq++)
#pragma unroll
      for (int kt = 0; kt < 2; kt++) {
        const bf16x8 kfr = ld8(sK + (32 * hf + 16 * kt + i) * KLD + 32 * kq + 8 * q4);
        sa[0][kt] = mfma16(kfr, qf[0][kq], sa[0][kt]);
        sa[1][kt] = mfma16(kfr, qf[1][kq], sa[1][kt]);
      }
    bf16x8 pf[2];
#pragma unroll
    for (int hd = 0; hd < 2; hd++) {
      float lsum = 0.f;
#pragma unroll
      for (int e = 0; e < 8; e++) {
        const float pe = ((mb >> e) & 1u) ? __expf(fmaf(sa[hd][e >> 2][e & 3], scale, -m_ref[hd])) : 0.f;
        pf[hd][e] = (short)f2bf(pe);
        lsum += pe;
      }
      l_run[hd] += lsum;
    }
#pragma unroll
    for (int dt = 0; dt < 8; dt++) {
      const bf16_t* vp = sVT + (16 * dt + i) * VLD + 32 * hf + 4 * q4;
      uint2 lo = *(const uint2*)vp, hi = *(const uint2*)(vp + 16);
      uint4 av = {lo.x, lo.y, hi.x, hi.y};
      O[0][dt] = mfma16(*(bf16x8*)&av, pf[0], O[0][dt]);
      O[1][dt] = mfma16(*(bf16x8*)&av, pf[1], O[1][dt]);
    }
  }
  __syncthreads();
#pragma unroll
  for (int hd = 0; hd < 2; hd++) {
    l_run[hd] += __shfl_xor(l_run[hd], 16, 64);
    l_run[hd] += __shfl_xor(l_run[hd], 32, 64);
  }
  float* mO = (float*)(smem + DSA_OFF_STAGE);
  float* mML = mO + 2 * 2 * 8 * 64 * 4;
  if (hf == 1) {
#pragma unroll
    for (int hd = 0; hd < 2; hd++) {
#pragma unroll
      for (int dt = 0; dt < 8; dt++) *(f32x4*)(mO + ((((hp * 2 + hd) * 8 + dt) * 64 + lane) << 2)) = O[hd][dt];
      mML[(hp * 2 + hd) * 64 + lane] = l_run[hd];
    }
  }
  __syncthreads();
  if (hf == 0) {
    bf16_t* ys = (bf16_t*)(ws + OFF_YS) + (size_t)2 * T * 512;
    const size_t tok = (size_t)(b * SEQ + t0 + i);
#pragma unroll
    for (int hd = 0; hd < 2; hd++) {
      const float linv = 1.f / (l_run[hd] + mML[(hp * 2 + hd) * 64 + lane]);
      const int head = 2 * hp + hd;
#pragma unroll
      for (int dt = 0; dt < 8; dt++) {
        const f32x4 o1 = *(const f32x4*)(mO + ((((hp * 2 + hd) * 8 + dt) * 64 + lane) << 2));
        const int d = 16 * dt + 4 * q4;
        const uint2 zz = *(const uint2*)(projb + tok * PJ + C_ZC + head * 128 + d);
        const float o0 = (O[hd][dt][0] + o1[0]) * linv * siluf(lo2f(zz.x));
        const float o1v = (O[hd][dt][1] + o1[1]) * linv * siluf(hi2f(zz.x));
        const float o2 = (O[hd][dt][2] + o1[2]) * linv * siluf(lo2f(zz.y));
        const float o3 = (O[hd][dt][3] + o1[3]) * linv * siluf(hi2f(zz.y));
        uint2 pk2 = {pack2(o0, o1v), pack2(o2, o3)};
        *(uint2*)(ys + tok * 512 + head * 128 + d) = pk2;
      }
    }
  }
}

DEVI void phaseE(const Params& p, int l, char* smem) {
  char* ws = p.ws;
  const bf16_t* yg = (const bf16_t*)(ws + OFF_YG);
  const bf16_t* W = (const bf16_t*)(ws + OFF_WGLU) + (size_t)l * 512 * 512;
  const bf16_t* projb = (const bf16_t*)(ws + OFF_PROJ);
  bf16_t* ys = (bf16_t*)(ws + OFF_YS);
  for (int id = blockIdx.x; id < 128 * 4; id += gridDim.x) {
    const int m0 = (id >> 2) * 128, n0 = (id & 3) * 128;
    f32x16 acc[2][2];
    zero_acc<2>(acc);
    gemm_mainloop<2>(yg + (size_t)m0 * 512, 512, W + (size_t)n0 * 512, 512, 512, smem, acc);
    gemm_epilogue<2>(acc, [&](int ml, int nl, f32x4 v) {
      const size_t m = m0 + ml;
      const int n = n0 + nl;
      const float4 gb = *(const float4*)(p.in[12] + l * 512 + n);
      const uint2 gg = *(const uint2*)(yg + m * 512 + n);
      const uint2 zz = *(const uint2*)(projb + m * PJ + C_ZA + n);
      const float o0 = lo2f(gg.x) * sigmf(v[0] + gb.x) * siluf(lo2f(zz.x));
      const float o1 = hi2f(gg.x) * sigmf(v[1] + gb.y) * siluf(hi2f(zz.x));
      const float o2 = lo2f(gg.y) * sigmf(v[2] + gb.z) * siluf(lo2f(zz.y));
      const float o3 = hi2f(gg.y) * sigmf(v[3] + gb.w) * siluf(hi2f(zz.y));
      uint2 pk = {pack2(o0, o1), pack2(o2, o3)};
      *(uint2*)(ys + m * 512 + n) = pk;
    });
  }
}

DEVI void phaseF(const Params& p, int l, char* smem) {
  char* ws = p.ws;
  const bf16_t* Wb = (const bf16_t*)(ws + OFF_WBR) + (size_t)l * 3 * 1024 * 512;
  const bf16_t* ys = (const bf16_t*)(ws + OFF_YS);
  const unsigned char* gates = (const unsigned char*)(ws + OFF_GATES);
  bf16_t* merged = (bf16_t*)(ws + OFF_QQ);
  const int lane = tidx() & 63, w = tidx() >> 6;
  const int r = lane & 31, hh = lane >> 5, wm = w & 1, wn = w >> 1;
  for (int id = blockIdx.x; id < 128 * 8; id += gridDim.x) {
    const int m0 = (id >> 3) * 128, n0 = (id & 7) * 128;
    f32x16 mg[2][2];
    zero_acc<2>(mg);
#pragma unroll 1
    for (int n = 0; n < 3; n++) {
      f32x16 acc[2][2];
      zero_acc<2>(acc);
      gemm_mainloop<2>(ys + (size_t)n * T * 512 + (size_t)m0 * 512, 512, Wb + (size_t)(n * 1024 + n0) * 512, 512, 512, smem, acc);
      unsigned char* sG = (unsigned char*)smem;
      __syncthreads();
      {
        const int tid = tidx();
#pragma unroll
        for (int j = 0; j < 4; j++) {
          const int c = tid + 256 * j;
          const int row = c >> 3, col = (c & 7) * 16;
          *(uint4*)(sG + row * 144 + col) = *(const uint4*)(gates + (size_t)(m0 + row) * 3072 + n * 1024 + n0 + col);
        }
      }
      __syncthreads();
#pragma unroll
      for (int ni = 0; ni < 2; ni++)
#pragma unroll
        for (int mi = 0; mi < 2; mi++)
#pragma unroll
          for (int g = 0; g < 4; g++) {
            const int ml = wm * 64 + mi * 32 + r;
            const int nl = wn * 64 + ni * 32 + 8 * g + 4 * hh;
            const unsigned gv = *(const unsigned*)(sG + ml * 144 + nl);
            const float k255 = 1.f / 255.f;
            mg[ni][mi][4 * g + 0] = fmaf((float)(gv & 255u) * k255, acc[ni][mi][4 * g + 0], mg[ni][mi][4 * g + 0]);
            mg[ni][mi][4 * g + 1] = fmaf((float)((gv >> 8) & 255u) * k255, acc[ni][mi][4 * g + 1], mg[ni][mi][4 * g + 1]);
            mg[ni][mi][4 * g + 2] = fmaf((float)((gv >> 16) & 255u) * k255, acc[ni][mi][4 * g + 2], mg[ni][mi][4 * g + 2]);
            mg[ni][mi][4 * g + 3] = fmaf((float)(gv >> 24) * k255, acc[ni][mi][4 * g + 3], mg[ni][mi][4 * g + 3]);
          }
    }
    {
      bf16_t* sT = (bf16_t*)smem;
      __syncthreads();
      gemm_epilogue<2>(mg, [&](int ml, int nl, f32x4 v) {
        uint2 pk = {pack2(v[0], v[1]), pack2(v[2], v[3])};
        *(uint2*)(sT + ml * 136 + nl) = pk;
      });
      __syncthreads();
      const int tid = tidx();
#pragma unroll
      for (int j = 0; j < 8; j++) {
        const int c = tid + 256 * j;
        const int row = c >> 4, col = (c & 15) * 8;
        *(uint4*)(merged + (size_t)(m0 + row) * 1024 + n0 + col) = *(const uint4*)(sT + row * 136 + col);
      }
    }
  }
}

DEVI void phaseG(const Params& p, int l, char* smem) {
  char* ws = p.ws;
  const bf16_t* merged = (const bf16_t*)(ws + OFF_QQ);
  const bf16_t* W = (const bf16_t*)(ws + OFF_WOUT) + (size_t)l * 1024 * 1024;
  bf16_t* xb = (bf16_t*)(ws + OFF_XB);
  float* rowsq = (float*)(ws + OFF_ROWSQ);
  float* sSq = (float*)(smem + 2 * 128 * GLD * 2);
  const int lane = tidx() & 63, w = tidx() >> 6;
  const int r = lane & 31, hh = lane >> 5, wm = w & 1, wn = w >> 1;
  for (int id = blockIdx.x; id < 128 * 8; id += gridDim.x) {
    const int m0 = (id >> 3) * 128, nt = id & 7, n0 = nt * 128;
    f32x16 acc[2][2];
    zero_acc<2>(acc);
    gemm_mainloop<2>(merged + (size_t)m0 * 1024, 1024, W + (size_t)n0 * 1024, 1024, 1024, smem, acc);
    float sq[2] = {0.f, 0.f};
#pragma unroll
    for (int ni = 0; ni < 2; ni++)
#pragma unroll
      for (int mi = 0; mi < 2; mi++)
#pragma unroll
        for (int g = 0; g < 4; g++) {
          const size_t m = m0 + wm * 64 + mi * 32 + r;
          const int n = n0 + wn * 64 + ni * 32 + 8 * g + 4 * hh;
          float4 xo = *(const float4*)(p.out + m * 1024 + n);
          xo.x += acc[ni][mi][4 * g]; xo.y += acc[ni][mi][4 * g + 1];
          xo.z += acc[ni][mi][4 * g + 2]; xo.w += acc[ni][mi][4 * g + 3];
          *(float4*)(p.out + m * 1024 + n) = xo;
          uint2 pk = {pack2(xo.x, xo.y), pack2(xo.z, xo.w)};
          *(uint2*)(xb + m * 1024 + n) = pk;
          sq[mi] += xo.x * xo.x + xo.y * xo.y + xo.z * xo.z + xo.w * xo.w;
        }
    sq[0] += shx32(sq[0]);
    sq[1] += shx32(sq[1]);
    __syncthreads();
    if (hh == 0) {
      sSq[wn * 128 + wm * 64 + r] = sq[0];
      sSq[wn * 128 + wm * 64 + 32 + r] = sq[1];
    }
    __syncthreads();
    if (tidx() < 128) rowsq[(size_t)(m0 + tidx()) * 8 + nt] = sSq[tidx()] + sSq[128 + tidx()];
  }
}

DEVI void phase_final(const Params& p) {
  const float* rowsq = (const float*)(p.ws + OFF_ROWSQ);
  const int lane = tidx() & 63, w = tidx() >> 6;
  for (int row = blockIdx.x * 4 + w; row < T; row += gridDim.x * 4) {
    const float4 a = *(const float4*)(rowsq + (size_t)row * 8);
    const float4 b = *(const float4*)(rowsq + (size_t)row * 8 + 4);
    const float s = ((a.x + a.y) + (a.z + a.w)) + ((b.x + b.y) + (b.z + b.w));
    const float rs = rsqrtf(s * (1.f / 1024.f) + EPS);
#pragma unroll
    for (int i = 0; i < 4; i++) {
      float4 v = *(const float4*)(p.out + (size_t)row * 1024 + i * 256 + lane * 4);
      const float4 g = *(const float4*)(p.in[25] + i * 256 + lane * 4);
      v.x *= rs * g.x; v.y *= rs * g.y; v.z *= rs * g.z; v.w *= rs * g.w;
      *(float4*)(p.out + (size_t)row * 1024 + i * 256 + lane * 4) = v;
    }
  }
}


DEVI void gsync(cg::grid_group& grid) {
  __builtin_amdgcn_fence(__ATOMIC_RELEASE, "agent");
  asm volatile("s_waitcnt vmcnt(0)" ::: "memory");
  grid.sync();
  __builtin_amdgcn_fence(__ATOMIC_ACQUIRE, "agent");
  asm volatile("s_waitcnt vmcnt(0)" ::: "memory");
}
DEVI void gbar(unsigned* ctr, unsigned& epoch) {
  asm volatile("s_waitcnt vmcnt(0)" ::: "memory");
  __syncthreads();
  epoch += 8;
  if (tidx() == 0) {
    __builtin_amdgcn_fence(__ATOMIC_RELEASE, "agent");
    asm volatile("s_waitcnt vmcnt(0)" ::: "memory");
    const unsigned g = blockIdx.x & 7u;
    const unsigned per = (gridDim.x + 7u - g) >> 3;
    const unsigned gen = epoch >> 3;
    const unsigned old = __hip_atomic_fetch_add(ctr + 32 * (1 + g), 1u, __ATOMIC_RELAXED, __HIP_MEMORY_SCOPE_AGENT);
    if ((old + 1u) % per == 0u) {
      const unsigned o2 = __hip_atomic_fetch_add(ctr, 1u, __ATOMIC_RELAXED, __HIP_MEMORY_SCOPE_AGENT);
      if (o2 + 1u == epoch) {
#pragma unroll
        for (int k = 0; k < 8; k++) __hip_atomic_store(ctr + 32 * (9 + k), gen, __ATOMIC_RELAXED, __HIP_MEMORY_SCOPE_AGENT);
      }
    }
    while (__hip_atomic_load(ctr + 32 * (9 + g), __ATOMIC_RELAXED, __HIP_MEMORY_SCOPE_AGENT) < gen) __builtin_amdgcn_s_sleep(1);
    __builtin_amdgcn_fence(__ATOMIC_ACQUIRE, "agent");
    asm volatile("s_waitcnt vmcnt(0)" ::: "memory");
  }
  __syncthreads();
}
__global__ void __launch_bounds__(256, 2) fwd_megakernel(Params p) {
  cg::grid_group grid = cg::this_grid();
  __shared__ __attribute__((aligned(16))) char smem[SMEM_BYTES];
  const int G = gridDim.x;
  unsigned* bar_ctr = (unsigned*)(p.ws + OFF_BAR);
  unsigned bar_epoch = 0;
  if (blockIdx.x == 0 && tidx() < 17) __hip_atomic_store(bar_ctr + 32 * tidx(), 0u, __ATOMIC_RELAXED, __HIP_MEMORY_SCOPE_AGENT);
  if (blockIdx.x == 0 && tidx() < 8) __hip_atomic_store((unsigned*)(p.ws + OFF_KMAX) + tidx(), 0u, __ATOMIC_RELAXED, __HIP_MEMORY_SCOPE_AGENT);
  phase0(p, smem);
  gsync(grid);
  for (int l = 0; l < DEPTH; l++) {
    phase1(p, l, smem);
    gbar(bar_ctr, bar_epoch);
    s5_chunk_tasks<0>(p, l, smem);
    gbar(bar_ctr, bar_epoch);
    for (int id = blockIdx.x; id < 1024; id += G) mlstm_local(p, l, id, smem);
    for (int id = blockIdx.x; id < 1024; id += G) qq_tile(p, l, id, smem);
    for (int id = blockIdx.x; id < T / 64; id += G) kiv_task(p, l, id, smem);
    gbar(bar_ctr, bar_epoch);
    for (int cid = blockIdx.x; cid < 88; cid += G) {
      if (cid < 72) mlstm_carry(p, cid, smem);
      else s5_carry(p, l, (cid - 72) * 256 + tidx());
    }
    gbar(bar_ctr, bar_epoch);
    for (int id = blockIdx.x; id < 512; id += G) {
#pragma unroll 1
      for (int k = 0; k < 2; k++) {
        const int rank = k ? (1023 - id) : id;
        const int b = rank & 1, qb = 511 - (rank >> 1);
        dsa_task(p, l, b, qb * QB, smem);
      }
    }
    for (int id = blockIdx.x; id < 1024; id += G) mlstm_out(p, l, id, smem);
    gbar(bar_ctr, bar_epoch);
    s5_chunk_tasks<1>(p, l, smem);
    gbar(bar_ctr, bar_epoch);
    phaseE(p, l, smem);
    gbar(bar_ctr, bar_epoch);
    phaseF(p, l, smem);
    gbar(bar_ctr, bar_epoch);
    phaseG(p, l, smem);
    gbar(bar_ctr, bar_epoch);
  }
  phase_final(p);
}

extern "C" void kernel_launch(void* const* d_in, const int* in_sizes, int n_in, void* d_out, int out_size, void* d_ws,
                              size_t ws_size, hipStream_t stream) {
  static int grid_blocks = 0;
  if (!grid_blocks) {
    int dev = 0, cus = 0, per_cu = 0;
    (void)hipGetDevice(&dev);
    (void)hipDeviceGetAttribute(&cus, hipDeviceAttributeMultiprocessorCount, dev);
    (void)hipOccupancyMaxActiveBlocksPerMultiprocessor(&per_cu, fwd_megakernel, 256, 0);
    if (per_cu > 2) per_cu = 2;
    if (per_cu < 1) per_cu = 1;
    grid_blocks = cus * per_cu;
  }
  if (ws_size < WS_TOTAL) {
    fprintf(stderr, "workspace too small: %zu < %zu\n", ws_size, (size_t)WS_TOTAL);
    return;
  }
  Params p{};
  for (int i = 0; i < 26; i++) p.in[i] = (const float*)d_in[i];
  p.out = (float*)d_out;
  p.ws = (char*)d_ws;
  void* args[] = {&p};
  hipError_t e = hipLaunchCooperativeKernel((void*)fwd_megakernel, dim3(grid_blocks), dim3(256), args, 0, stream);
  if (e != hipSuccess) fprintf(stderr, "cooperative launch failed: %s (grid %d)\n", hipGetErrorString(e), grid_blocks);
}
```

```cpp
#include <hip/hip_runtime.h>
#include <hip/hip_bf16.h>
#include <hip/hip_cooperative_groups.h>
#include <cstdio>
namespace cg = cooperative_groups;

#define DEVI __device__ __forceinline__
typedef unsigned short bf16_t;
typedef __attribute__((ext_vector_type(8))) short bf16x8;
typedef __attribute__((ext_vector_type(16))) float f32x16;
typedef __attribute__((ext_vector_type(4))) float f32x4;
typedef __attribute__((ext_vector_type(4))) unsigned u32x4;

constexpr int D = 1024, SEQ = 8192, NB = 2, T = NB * SEQ, DEPTH = 4;
constexpr int INW = 7248;
constexpr int N1 = 4224;
constexpr int NWIN = 7296;
constexpr int PJ = 4224;
constexpr int C_UA = 0, C_ZA = 512, C_QB = 1024, C_KB = 1536, C_VB = 2048, C_ZB = 2560, C_CQ = 3072,
              C_KC = 3328, C_VC = 3456, C_KIDX = 3584, C_ZC = 3648, C_SMALL = 4160;
constexpr float EPS = 1e-6f;

constexpr size_t SZ_WIN = (size_t)DEPTH * NWIN * 1024 * 2;
constexpr size_t SZ_WGLU = (size_t)DEPTH * 512 * 512 * 2;
constexpr size_t SZ_WQ = (size_t)DEPTH * 1024 * 256 * 2;
constexpr size_t SZ_WBR = (size_t)DEPTH * 3 * 1024 * 512 * 2;
constexpr size_t SZ_WOUT = (size_t)DEPTH * 1024 * 1024 * 2;
constexpr size_t OFF_WIN = 0;
constexpr size_t OFF_WGLU = OFF_WIN + SZ_WIN;
constexpr size_t OFF_WQ = OFF_WGLU + SZ_WGLU;
constexpr size_t OFF_WBR = OFF_WQ + SZ_WQ;
constexpr size_t OFF_WOUT = OFF_WBR + SZ_WBR;
constexpr size_t OFF_XB = OFF_WOUT + SZ_WOUT;
constexpr size_t OFF_ROWSQ = OFF_XB + (size_t)T * 1024 * 2;
constexpr size_t OFF_PROJ = OFF_ROWSQ + (size_t)T * 8 * 4;
constexpr size_t OFF_SMALL = OFF_PROJ + (size_t)T * PJ * 2;
constexpr size_t OFF_QQ = OFF_SMALL + (size_t)T * 16 * 4;
constexpr size_t OFF_KI = OFF_QQ + (size_t)T * 1024 * 2;
constexpr size_t OFF_VT = OFF_KI + (size_t)T * 64 * 2;
constexpr size_t OFF_S5ST = OFF_VT + (size_t)NB * 128 * SEQ * 2;
constexpr size_t OFF_MCT = OFF_S5ST + (size_t)NB * 32 * 128 * 64 * 8;
constexpr size_t OFF_MN = OFF_MCT + (size_t)8 * 128 * 128 * 128 * 2;
constexpr size_t OFF_MSC = OFF_MN + (size_t)8 * 128 * 128 * 4;
constexpr size_t OFF_YG = OFF_MSC + (size_t)3 * 8 * 128 * 4;
constexpr size_t OFF_YS = OFF_YG + (size_t)T * 512 * 2;
constexpr size_t OFF_BAR = OFF_YS + (size_t)3 * T * 512 * 2;
constexpr size_t OFF_GATES = OFF_BAR + 2048;
constexpr size_t OFF_KMAX = OFF_GATES + (size_t)T * 3072;
constexpr size_t WS_TOTAL = OFF_KMAX + 256;

constexpr int SMEM_BYTES = 59392;

struct Params {
  const float* in[26];
  float* out;
  char* ws;
};

DEVI int tidx() { int t = threadIdx.x; asm volatile("" : "+v"(t)); return t; }
typedef float f32x2_t __attribute__((ext_vector_type(2)));
typedef __bf16 bf16x2_t __attribute__((ext_vector_type(2)));
DEVI bf16_t f2bf(float f) {
  __bf16 h = (__bf16)f;
  return __builtin_bit_cast(unsigned short, h);
}
DEVI float bf2f(bf16_t h) { return __uint_as_float(((unsigned)h) << 16); }
DEVI unsigned pack2(float a, float b) {
  f32x2_t v = {a, b};
  bf16x2_t h = __builtin_convertvector(v, bf16x2_t);
  return __builtin_bit_cast(unsigned, h);
}
DEVI float lo2f(unsigned u) { return __uint_as_float(u << 16); }
DEVI float hi2f(unsigned u) { return __uint_as_float(u & 0xffff0000u); }
DEVI float sigmf(float x) { return __builtin_amdgcn_rcpf(1.f + __expf(-x)); }
DEVI float siluf(float x) { return x * sigmf(x); }
DEVI float geluf(float x) {
  float u = 0.7978845608028654f * (x + 0.044715f * x * x * x);
  return x * sigmf(2.f * u);
}
DEVI f32x16 mfma32(bf16x8 a, bf16x8 b, f32x16 c) { return __builtin_amdgcn_mfma_f32_32x32x16_bf16(a, b, c, 0, 0, 0); }
DEVI f32x4 mfma16(bf16x8 a, bf16x8 b, f32x4 c) { return __builtin_amdgcn_mfma_f32_16x16x32_bf16(a, b, c, 0, 0, 0); }
DEVI bf16x8 ld8(const bf16_t* p) { return *(const bf16x8*)p; }
DEVI float shx32(float v) { return __shfl_xor(v, 32, 64); }
DEVI void unpack8(uint4 v, float* f) {
  f[0] = lo2f(v.x); f[1] = hi2f(v.x); f[2] = lo2f(v.y); f[3] = hi2f(v.y);
  f[4] = lo2f(v.z); f[5] = hi2f(v.z); f[6] = lo2f(v.w); f[7] = hi2f(v.w);
}

constexpr int GLD = 72;
template <int NI>
DEVI void gemm_mainloop(const bf16_t* __restrict__ A, int lda, const bf16_t* __restrict__ Bt, int ldb, int K,
                        char* smem, f32x16 (&acc)[NI][2]) {
  bf16_t* sA = (bf16_t*)smem;
  bf16_t* sB = sA + 128 * GLD;
  const int tid = tidx(), lane = tid & 63, w = tid >> 6;
  const int wm = w & 1, wn = w >> 1;
  const int r = lane & 31, hh = lane >> 5;
  u32x4 ra0, ra1, ra2, ra3, rb0, rb1, rb2, rb3;
  const int lrow = tid >> 3, lcol = (tid & 7) * 8;
  const bf16_t* Ap = A + (size_t)lrow * lda + lcol;
  const bf16_t* Bp = Bt + (size_t)lrow * ldb + lcol;
  ra0 = *(const u32x4*)(Ap); ra1 = *(const u32x4*)(Ap + (size_t)32 * lda);
  ra2 = *(const u32x4*)(Ap + (size_t)64 * lda); ra3 = *(const u32x4*)(Ap + (size_t)96 * lda);
  rb0 = *(const u32x4*)(Bp); rb1 = *(const u32x4*)(Bp + (size_t)32 * ldb);
  if (NI == 2) { rb2 = *(const u32x4*)(Bp + (size_t)64 * ldb); rb3 = *(const u32x4*)(Bp + (size_t)96 * ldb); }
  bf16_t* sAw = sA + lrow * GLD + lcol;
  bf16_t* sBw = sB + lrow * GLD + lcol;
  for (int k0 = 0; k0 < K; k0 += 64) {
    __syncthreads();
    *(u32x4*)(sAw) = ra0; *(u32x4*)(sAw + 32 * GLD) = ra1; *(u32x4*)(sAw + 64 * GLD) = ra2; *(u32x4*)(sAw + 96 * GLD) = ra3;
    *(u32x4*)(sBw) = rb0; *(u32x4*)(sBw + 32 * GLD) = rb1;
    if (NI == 2) { *(u32x4*)(sBw + 64 * GLD) = rb2; *(u32x4*)(sBw + 96 * GLD) = rb3; }
    __syncthreads();
    if (k0 + 64 < K) {
      Ap += 64; Bp += 64;
      ra0 = *(const u32x4*)(Ap); ra1 = *(const u32x4*)(Ap + (size_t)32 * lda);
      ra2 = *(const u32x4*)(Ap + (size_t)64 * lda); ra3 = *(const u32x4*)(Ap + (size_t)96 * lda);
      rb0 = *(const u32x4*)(Bp); rb1 = *(const u32x4*)(Bp + (size_t)32 * ldb);
      if (NI == 2) { rb2 = *(const u32x4*)(Bp + (size_t)64 * ldb); rb3 = *(const u32x4*)(Bp + (size_t)96 * ldb); }
    }
#pragma unroll
    for (int ks = 0; ks < 4; ks++) {
      bf16x8 af[2], bfr[NI];
#pragma unroll
      for (int i = 0; i < 2; i++) af[i] = ld8(sA + (wm * 64 + i * 32 + r) * GLD + ks * 16 + hh * 8);
#pragma unroll
      for (int i = 0; i < NI; i++) bfr[i] = ld8(sB + (wn * 32 * NI + i * 32 + r) * GLD + ks * 16 + hh * 8);
#pragma unroll
      for (int ni = 0; ni < NI; ni++)
#pragma unroll
        for (int mi = 0; mi < 2; mi++) acc[ni][mi] = mfma32(bfr[ni], af[mi], acc[ni][mi]);
    }
  }
}
template <int NI, class Epi>
DEVI void gemm_epilogue(f32x16 (&acc)[NI][2], Epi epi) {
  const int tid = tidx(), lane = tid & 63, w = tid >> 6;
  const int wm = w & 1, wn = w >> 1;
  const int r = lane & 31, hh = lane >> 5;
#pragma unroll
  for (int ni = 0; ni < NI; ni++)
#pragma unroll
    for (int mi = 0; mi < 2; mi++)
#pragma unroll
      for (int g = 0; g < 4; g++) {
        f32x4 v = {acc[ni][mi][4 * g], acc[ni][mi][4 * g + 1], acc[ni][mi][4 * g + 2], acc[ni][mi][4 * g + 3]};
        epi(wm * 64 + mi * 32 + r, wn * 32 * NI + ni * 32 + 8 * g + 4 * hh, v);
      }
}
template <int NI>
DEVI void zero_acc(f32x16 (&acc)[NI][2]) {
#pragma unroll
  for (int a = 0; a < NI; a++)
#pragma unroll
    for (int b = 0; b < 2; b++)
#pragma unroll
      for (int i = 0; i < 16; i++) acc[a][b][i] = 0.f;
}

DEVI int inmap(int n) {
  if (n < 2560) return n;
  if (n < 3648) return n + 8;
  if (n < 4160) return n + 16;
  if (n < 4168) return 2560 + (n - 4160);
  if (n < 4176) return 3656 + (n - 4168);
  if (n < 4224) return -1;
  return 4176 + (n - 4224);
}
DEVI void convT_tile(const float* __restrict__ src, int ld_src, const float* __restrict__ ksc, bf16_t* __restrict__ dst,
                     int K, int n0, int k0, bool use_map, char* smem) {
  bf16_t* s = (bf16_t*)smem;
  const int tid = tidx();
#pragma unroll
  for (int i = 0; i < 4; i++) {
    const int e = tid + 256 * i;
    const int kk = e >> 4, n4 = (e & 15) * 4;
    const int col = use_map ? inmap(n0 + n4) : (n0 + n4);
    float4 v = {0.f, 0.f, 0.f, 0.f};
    if (col >= 0) {
      v = *(const float4*)(src + (size_t)(k0 + kk) * ld_src + col);
      if (ksc) { const float g = ksc[k0 + kk]; v.x *= g; v.y *= g; v.z *= g; v.w *= g; }
    }
    s[(n4 + 0) * 72 + kk] = f2bf(v.x);
    s[(n4 + 1) * 72 + kk] = f2bf(v.y);
    s[(n4 + 2) * 72 + kk] = f2bf(v.z);
    s[(n4 + 3) * 72 + kk] = f2bf(v.w);
  }
  __syncthreads();
#pragma unroll
  for (int i = 0; i < 2; i++) {
    int e = tid + 256 * i;
    int nn = e >> 3, c8 = e & 7;
    *(uint4*)(dst + (size_t)(n0 + nn) * K + k0 + c8 * 8) = *(const uint4*)(s + nn * 72 + c8 * 8);
  }
  __syncthreads();
}

DEVI void phase0(const Params& p, char* smem) {
  char* ws = p.ws;
  const int NT_IN = 4 * 114 * 16, NT_GLU = 4 * 64, NT_Q = 4 * 64, NT_BR = 4 * 384, NT_OUT = 4 * 256;
  const int total = NT_IN + NT_GLU + NT_Q + NT_BR + NT_OUT;
  for (int id = blockIdx.x; id < total; id += gridDim.x) {
    int j = id;
    if (j < NT_IN) {
      int l = j / (114 * 16), rr = j % (114 * 16);
      int nt = rr / 16, kt = rr % 16;
      convT_tile(p.in[2] + (size_t)l * 1024 * INW, INW, p.in[1] + l * 1024,
                 (bf16_t*)(ws + OFF_WIN) + (size_t)l * NWIN * 1024, 1024, nt * 64, kt * 64, true, smem);
      continue;
    }
    j -= NT_IN;
    if (j < NT_GLU) {
      int l = j / 64, rr = j % 64;
      convT_tile(p.in[11] + (size_t)l * 512 * 512, 512, nullptr, (bf16_t*)(ws + OFF_WGLU) + (size_t)l * 512 * 512, 512,
                 (rr / 8) * 64, (rr % 8) * 64, false, smem);
      continue;
    }
    j -= NT_GLU;
    if (j < NT_Q) {
      int l = j / 64, rr = j % 64;
      int which = rr / 32, r2 = rr % 32;
      const float* src = (which ? p.in[20] : p.in[19]) + (size_t)l * 256 * 512;
      convT_tile(src, 512, p.in[18] + l * 256, (bf16_t*)(ws + OFF_WQ) + (size_t)l * 1024 * 256 + (size_t)which * 512 * 256,
                 256, (r2 / 4) * 64, (r2 % 4) * 64, false, smem);
      continue;
    }
    j -= NT_Q;
    if (j < NT_BR) {
      int l = j / 384, rr = j % 384;
      int n = rr / 128, r2 = rr % 128;
      convT_tile(p.in[23] + ((size_t)l * 3 + n) * 512 * 1024, 1024, nullptr,
                 (bf16_t*)(ws + OFF_WBR) + ((size_t)l * 3 + n) * 1024 * 512, 512, (r2 / 8) * 64, (r2 % 8) * 64, false, smem);
      continue;
    }
    j -= NT_BR;
    {
      int l = j / 256, rr = j % 256;
      convT_tile(p.in[24] + (size_t)l * 1024 * 1024, 1024, nullptr, (bf16_t*)(ws + OFF_WOUT) + (size_t)l * 1024 * 1024,
                 1024, (rr / 16) * 64, (rr % 16) * 64, false, smem);
    }
  }
  const int lane = tidx() & 63, w = tidx() >> 6;
  bf16_t* xb = (bf16_t*)(ws + OFF_XB);
  float* rowsq = (float*)(ws + OFF_ROWSQ);
  for (int row = blockIdx.x * 4 + w; row < T; row += gridDim.x * 4) {
    const float* xr = p.in[0] + (size_t)row * 1024;
    float ss = 0.f;
#pragma unroll
    for (int i = 0; i < 4; i++) {
      float4 v = *(const float4*)(xr + i * 256 + lane * 4);
      *(float4*)(p.out + (size_t)row * 1024 + i * 256 + lane * 4) = v;
      uint2 pk = {pack2(v.x, v.y), pack2(v.z, v.w)};
      *(uint2*)(xb + (size_t)row * 1024 + i * 256 + lane * 4) = pk;
      ss += v.x * v.x + v.y * v.y + v.z * v.z + v.w * v.w;
    }
#pragma unroll
    for (int o = 32; o > 0; o >>= 1) ss += __shfl_xor(ss, o, 64);
    if (lane < 8) rowsq[(size_t)row * 8 + lane] = (lane == 0) ? ss : 0.f;
  }
}

DEVI void load_rowscale(const Params& p, int m0, float* rsc) {
  const float* rowsq = (const float*)(p.ws + OFF_ROWSQ);
  if (tidx() < 128) {
    const float4 a = *(const float4*)(rowsq + (size_t)(m0 + tidx()) * 8);
    const float4 b = *(const float4*)(rowsq + (size_t)(m0 + tidx()) * 8 + 4);
    float s = ((a.x + a.y) + (a.z + a.w)) + ((b.x + b.y) + (b.z + b.w));
    rsc[tidx()] = rsqrtf(s * (1.f / 1024.f) + EPS);
  }
}

DEVI void phase1(const Params& p, int l, char* smem) {
  char* ws = p.ws;
  const bf16_t* xb = (const bf16_t*)(ws + OFF_XB);
  const bf16_t* W = (const bf16_t*)(ws + OFF_WIN) + (size_t)l * NWIN * 1024;
  bf16_t* projb = (bf16_t*)(ws + OFF_PROJ);
  float* small = (float*)(ws + OFF_SMALL);
  unsigned char* gates = (unsigned char*)(ws + OFF_GATES);
  float* rsc = (float*)(smem + 2 * 128 * GLD * 2);
  for (int id = blockIdx.x; id < 128 * 57; id += gridDim.x) {
    const int mt = id / 57, nt = id % 57;
    const int m0 = mt * 128, n0 = nt * 128;
    __syncthreads();
    load_rowscale(p, m0, rsc);
    f32x16 acc[2][2];
    zero_acc<2>(acc);
    gemm_mainloop<2>(xb + (size_t)m0 * 1024, 1024, W + (size_t)n0 * 1024, 1024, 1024, smem, acc);
    if (nt == 32) {
      gemm_epilogue<2>(acc, [&](int ml, int nl, f32x4 v) {
        const float rs = rsc[ml];
        const int m = m0 + ml, n = n0 + nl;
        if (n < C_SMALL) {
          uint2 pk = {pack2(v[0] * rs, v[1] * rs), pack2(v[2] * rs, v[3] * rs)};
          *(uint2*)(projb + (size_t)m * PJ + n) = pk;
        } else if (n < C_SMALL + 16) {
          float4 o = {v[0] * rs, v[1] * rs, v[2] * rs, v[3] * rs};
          *(float4*)(small + (size_t)m * 16 + (n - C_SMALL)) = o;
        }
      });
    } else if (nt < 32) {
      bf16_t* sT = (bf16_t*)smem;
      __syncthreads();
      gemm_epilogue<2>(acc, [&](int ml, int nl, f32x4 v) {
        const float rs = rsc[ml];
        uint2 pk = {pack2(v[0] * rs, v[1] * rs), pack2(v[2] * rs, v[3] * rs)};
        *(uint2*)(sT + ml * 136 + nl) = pk;
      });
      __syncthreads();
      const int tid = tidx();
#pragma unroll
      for (int j = 0; j < 8; j++) {
        const int c = tid + 256 * j;
        const int row = c >> 4, col = (c & 15) * 8;
        *(uint4*)(projb + (size_t)(m0 + row) * PJ + n0 + col) = *(const uint4*)(sT + row * 136 + col);
      }
    } else {
      unsigned char* sG = (unsigned char*)smem;
      __syncthreads();
      gemm_epilogue<2>(acc, [&](int ml, int nl, f32x4 v) {
        const float rs = rsc[ml];
        const unsigned g0 = (unsigned)(sigmf(v[0] * rs) * 255.f + 0.5f), g1 = (unsigned)(sigmf(v[1] * rs) * 255.f + 0.5f);
        const unsigned g2 = (unsigned)(sigmf(v[2] * rs) * 255.f + 0.5f), g3 = (unsigned)(sigmf(v[3] * rs) * 255.f + 0.5f);
        *(unsigned*)(sG + ml * 144 + nl) = g0 | (g1 << 8) | (g2 << 16) | (g3 << 24);
      });
      __syncthreads();
      const int tid = tidx();
      const int gn0 = n0 - N1;
#pragma unroll
      for (int j = 0; j < 4; j++) {
        const int c = tid + 256 * j;
        const int row = c >> 3, col = (c & 7) * 16;
        *(uint4*)(gates + (size_t)(m0 + row) * 3072 + gn0 + col) = *(const uint4*)(sG + row * 144 + col);
      }
    }
  }
}

DEVI void s5_abar(const Params& p, int l, int g, int n, float& abr, float& abi, float& fr, float& fi) {
  const float dt = expf(p.in[9][l * 32 + g]);
  const float ar = p.in[3][(l * 32 + g) * 64 + n], ai = p.in[4][(l * 32 + g) * 64 + n];
  const float mag = expf(ar * dt), ang = ai * dt;
  float sn, cs;
  {
    float k = rintf(ang * 0.15915494309189535f);
    float rr = fmaf(-k, 6.28125f, ang);
    rr = fmaf(-k, 1.9353071795864769e-3f, rr);
    sn = sinf(rr);
    cs = cosf(rr);
  }
  abr = mag * cs;
  abi = mag * sn;
  const float den = ar * ar + ai * ai;
  fr = ((abr - 1.f) * ar + abi * ai) / den;
  fi = (abi * ar - (abr - 1.f) * ai) / den;
}

template <int MODE>
DEVI void s5_chunk_tasks(const Params& p, int l, char* smem) {
  char* ws = p.ws;
  const bf16_t* projb = (const bf16_t*)(ws + OFF_PROJ);
  float2* st = (float2*)(ws + OFF_S5ST);
  bf16_t* yg = (bf16_t*)(ws + OFF_YG);
  const int tid = tidx(), lane = tid & 63, w = tid >> 6;
  float* sU = (float*)smem + w * 1024;
  bf16_t* sH = (bf16_t*)(smem + 16384) + w * (16 * 136);
  const int ntask = NB * 32 * 128 / 4;
  for (int bt = blockIdx.x; bt < ntask; bt += gridDim.x) {
    const int task = bt * 4 + w;
    const int c = task & 127, g = (task >> 7) & 31, b = task >> 12;
    float abr, abi, fr, fi;
    s5_abar(p, l, g, lane, abr, abi, fr, fi);
    float bbr[16], bbi[16];
    {
      const float* br = p.in[5] + ((size_t)(l * 32 + g) * 64 + lane) * 16;
      const float* bi = p.in[6] + ((size_t)(l * 32 + g) * 64 + lane) * 16;
#pragma unroll
      for (int q = 0; q < 4; q++) {
        float4 x = *(const float4*)(br + 4 * q), y = *(const float4*)(bi + 4 * q);
        bbr[4 * q + 0] = fr * x.x - fi * y.x; bbi[4 * q + 0] = fr * y.x + fi * x.x;
        bbr[4 * q + 1] = fr * x.y - fi * y.y; bbi[4 * q + 1] = fr * y.y + fi * x.y;
        bbr[4 * q + 2] = fr * x.z - fi * y.z; bbi[4 * q + 2] = fr * y.z + fi * x.z;
        bbr[4 * q + 3] = fr * x.w - fi * y.w; bbi[4 * q + 3] = fr * y.w + fi * x.w;
      }
    }
    {
      const bf16_t* up = projb + (size_t)(b * SEQ + c * 64 + lane) * PJ + C_UA + g * 16;
      uint4 u0 = *(const uint4*)up, u1 = *(const uint4*)(up + 8);
      float f[16];
      unpack8(u0, f);
      unpack8(u1, f + 8);
#pragma unroll
      for (int q = 0; q < 4; q++) {
        float4 o = {f[4 * q], f[4 * q + 1], f[4 * q + 2], f[4 * q + 3]};
        *(float4*)(sU + lane * 16 + 4 * q) = o;
      }
    }
    const size_t sidx = ((size_t)(b * 32 + g) * 128 + c) * 64 + lane;
    float hr = 0.f, hi = 0.f;
    bf16x8 cf[4];
    if (MODE == 1) {
      float2 h0 = st[sidx];
      hr = h0.x; hi = h0.y;
      const int i = lane & 15, q4 = lane >> 4;
#pragma unroll
      for (int kq = 0; kq < 4; kq++) {
        const float* cp = (kq < 2 ? p.in[7] : p.in[8]) + ((size_t)(l * 32 + g) * 16 + i) * 64 + (kq & 1) * 32 + q4 * 8;
        float4 x = *(const float4*)cp, y = *(const float4*)(cp + 4);
        const float sg = kq < 2 ? 1.f : -1.f;
        bf16x8 v;
        v[0] = (short)f2bf(sg * x.x); v[1] = (short)f2bf(sg * x.y); v[2] = (short)f2bf(sg * x.z); v[3] = (short)f2bf(sg * x.w);
        v[4] = (short)f2bf(sg * y.x); v[5] = (short)f2bf(sg * y.y); v[6] = (short)f2bf(sg * y.z); v[7] = (short)f2bf(sg * y.w);
        cf[kq] = v;
      }
    }
    __syncthreads();
#pragma unroll 1
    for (int sub = 0; sub < 4; sub++) {
#pragma unroll 2
      for (int tt = 0; tt < 16; tt++) {
        const float* ur = sU + (sub * 16 + tt) * 16;
        float bur = 0.f, bui = 0.f;
#pragma unroll
        for (int q = 0; q < 4; q++) {
          float4 u = *(const float4*)(ur + 4 * q);
          bur = fmaf(u.x, bbr[4 * q], bur); bui = fmaf(u.x, bbi[4 * q], bui);
          bur = fmaf(u.y, bbr[4 * q + 1], bur); bui = fmaf(u.y, bbi[4 * q + 1], bui);
          bur = fmaf(u.z, bbr[4 * q + 2], bur); bui = fmaf(u.z, bbi[4 * q + 2], bui);
          bur = fmaf(u.w, bbr[4 * q + 3], bur); bui = fmaf(u.w, bbi[4 * q + 3], bui);
        }
        const float nr = abr * hr - abi * hi + bur;
        const float ni = abr * hi + abi * hr + bui;
        hr = nr; hi = ni;
        if (MODE == 1) {
          sH[tt * 136 + lane] = f2bf(hr);
          sH[tt * 136 + 64 + lane] = f2bf(hi);
        }
      }
      if (MODE == 1) {
        __syncthreads();
        const int i = lane & 15, q4 = lane >> 4;
        f32x4 acc = {0.f, 0.f, 0.f, 0.f};
#pragma unroll
        for (int kq = 0; kq < 4; kq++) acc = mfma16(cf[kq], ld8(sH + i * 136 + kq * 32 + q4 * 8), acc);
        const int t = sub * 16 + i;
        const float4 uu = *(const float4*)(sU + t * 16 + 4 * q4);
        const float4 dd = *(const float4*)(p.in[10] + l * 512 + g * 16 + 4 * q4);
        const float y0 = geluf(acc[0] + dd.x * uu.x), y1 = geluf(acc[1] + dd.y * uu.y);
        const float y2 = geluf(acc[2] + dd.z * uu.z), y3 = geluf(acc[3] + dd.w * uu.w);
        uint2 pk = {pack2(y0, y1), pack2(y2, y3)};
        *(uint2*)(yg + (size_t)(b * SEQ + c * 64 + t) * 512 + g * 16 + 4 * q4) = pk;
        __syncthreads();
      }
    }
    if (MODE == 0) {
      st[sidx] = make_float2(hr, hi);
    }
    __syncthreads();
  }
}

DEVI void s5_carry(const Params& p, int l, int idx) {
  float2* st = (float2*)(p.ws + OFF_S5ST);
  const int n = idx & 63, g = (idx >> 6) & 31, b = idx >> 11;
  float abr, abi, fr, fi;
  s5_abar(p, l, g, n, abr, abi, fr, fi);
  float pr = abr, pi = abi;
#pragma unroll
  for (int i = 0; i < 6; i++) {
    float nr = pr * pr - pi * pi, ni = 2.f * pr * pi;
    pr = nr; pi = ni;
  }
  float hr = 0.f, hi = 0.f;
  float2* s = st + ((size_t)(b * 32 + g) * 128) * 64 + n;
#pragma unroll 1
  for (int c0 = 0; c0 < 128; c0 += 16) {
    float2 e[16];
#pragma unroll
    for (int j = 0; j < 16; j++) e[j] = s[(size_t)(c0 + j) * 64];
#pragma unroll
    for (int j = 0; j < 16; j++) {
      s[(size_t)(c0 + j) * 64] = make_float2(hr, hi);
      const float nr = pr * hr - pi * hi + e[j].x;
      const float ni = pr * hi + pi * hr + e[j].y;
      hr = nr; hi = ni;
    }
  }
}

template <bool TRANSPOSED>
DEVI void conv_tile(const Params& p, int l, int b, int c, int h, int which, float scale, const float* rowscale, bf16_t* dst) {
  const bf16_t* projb = (const bf16_t*)(p.ws + OFF_PROJ);
  const int tid = tidx();
  const float* cw = p.in[13] + (size_t)l * 4 * 1024;
  const float* cb = p.in[14] + (size_t)l * 1024;
#pragma unroll
  for (int i = 0; i < 4; i++) {
    const int e = tid + 256 * i;
    const int tt = e >> 4, d8 = (e & 15) * 8;
    const int ch = which * 512 + h * 128 + d8;
    const int t = c * 64 + tt;
    float acc[8];
    {
      float4 b0 = *(const float4*)(cb + ch), b1 = *(const float4*)(cb + ch + 4);
      acc[0] = b0.x; acc[1] = b0.y; acc[2] = b0.z; acc[3] = b0.w;
      acc[4] = b1.x; acc[5] = b1.y; acc[6] = b1.z; acc[7] = b1.w;
    }
#pragma unroll
    for (int j = 0; j < 4; j++) {
      const int ts = t - 3 + j;
      if (ts >= 0) {
        uint4 xv = *(const uint4*)(projb + (size_t)(b * SEQ + ts) * PJ + C_QB + ch);
        float xf[8];
        unpack8(xv, xf);
        float4 w0 = *(const float4*)(cw + j * 1024 + ch), w1 = *(const float4*)(cw + j * 1024 + ch + 4);
        acc[0] = fmaf(w0.x, xf[0], acc[0]); acc[1] = fmaf(w0.y, xf[1], acc[1]);
        acc[2] = fmaf(w0.z, xf[2], acc[2]); acc[3] = fmaf(w0.w, xf[3], acc[3]);
        acc[4] = fmaf(w1.x, xf[4], acc[4]); acc[5] = fmaf(w1.y, xf[5], acc[5]);
        acc[6] = fmaf(w1.z, xf[6], acc[6]); acc[7] = fmaf(w1.w, xf[7], acc[7]);
      }
    }
    const float sc = rowscale ? scale * rowscale[tt] : scale;
#pragma unroll
    for (int q = 0; q < 8; q++) acc[q] = siluf(acc[q]) * sc;
    if (!TRANSPOSED) {
      uint4 o = {pack2(acc[0], acc[1]), pack2(acc[2], acc[3]), pack2(acc[4], acc[5]), pack2(acc[6], acc[7])};
      *(uint4*)(dst + tt * 136 + d8) = o;
    } else {
#pragma unroll
      for (int q = 0; q < 8; q++) dst[(d8 + q) * 72 + tt] = f2bf(acc[q]);
    }
  }
}
DEVI void vT_tile(const Params& p, int b, int c, int h, bf16_t* dst) {
  const bf16_t* projb = (const bf16_t*)(p.ws + OFF_PROJ);
  const int tid = tidx();
#pragma unroll
  for (int i = 0; i < 4; i++) {
    const int e = tid + 256 * i;
    const int tt = e >> 4, d8 = (e & 15) * 8;
    uint4 xv = *(const uint4*)(projb + (size_t)(b * SEQ + c * 64 + tt) * PJ + C_VB + h * 128 + d8);
    dst[(d8 + 0) * 72 + tt] = (bf16_t)(xv.x & 0xffffu);
    dst[(d8 + 1) * 72 + tt] = (bf16_t)(xv.x >> 16);
    dst[(d8 + 2) * 72 + tt] = (bf16_t)(xv.y & 0xffffu);
    dst[(d8 + 3) * 72 + tt] = (bf16_t)(xv.y >> 16);
    dst[(d8 + 4) * 72 + tt] = (bf16_t)(xv.z & 0xffffu);
    dst[(d8 + 5) * 72 + tt] = (bf16_t)(xv.z >> 16);
    dst[(d8 + 6) * 72 + tt] = (bf16_t)(xv.w & 0xffffu);
    dst[(d8 + 7) * 72 + tt] = (bf16_t)(xv.w >> 16);
  }
}
DEVI float logsigf(float x) { return fminf(x, 0.f) - log1pf(expf(-fabsf(x))); }

DEVI void mlstm_local(const Params& p, int l, int task, char* smem) {
  char* ws = p.ws;
  const int tid = tidx(), lane = tid & 63, w = tid >> 6;
  const int c = task & 127, h = (task >> 7) & 3, b = task >> 9;
  const int bh = b * 4 + h;
  bf16_t* sKT = (bf16_t*)smem;
  bf16_t* sVT = sKT + 128 * 72;
  float* sW = (float*)(smem + 2 * 128 * 72 * 2);
  const float* small = (const float*)(ws + OFF_SMALL);
  float* msc = (float*)(ws + OFF_MSC);
  __syncthreads();
  if (w == 0) {
    const size_t row = (size_t)(b * SEQ + c * 64 + lane) * 16;
    const float ipre = small[row + h] + p.in[15][l * 4 + h];
    const float lf = logsigf(small[row + 4 + h] + p.in[16][l * 4 + h]);
    float bc = lf;
#pragma unroll
    for (int o = 1; o < 64; o <<= 1) {
      float v = __shfl_up(bc, o, 64);
      if (lane >= o) bc += v;
    }
    const float blast = __shfl(bc, 63, 64);
    const float ge = blast - bc + ipre;
    float mx = ge;
#pragma unroll
    for (int o = 32; o > 0; o >>= 1) mx = fmaxf(mx, __shfl_xor(mx, o, 64));
    sW[lane] = expf(ge - mx);
    if (lane == 0) {
      msc[bh * 128 + c] = mx;
      msc[1024 + bh * 128 + c] = blast;
    }
  }
  __syncthreads();
  conv_tile<true>(p, l, b, c, h, 1, 0.08838834764831845f, sW, sKT);
  vT_tile(p, b, c, h, sVT);
  __syncthreads();
  if (tid < 128) {
    float s = 0.f;
    for (int t = 0; t < 64; t++) s += bf2f(sKT[tid * 72 + t]);
    ((float*)(ws + OFF_MN))[((size_t)bh * 128 + c) * 128 + tid] = s;
  }
  const int r = lane & 31, hh = lane >> 5;
  f32x16 acc[4];
#pragma unroll
  for (int ci = 0; ci < 4; ci++)
#pragma unroll
    for (int i = 0; i < 16; i++) acc[ci][i] = 0.f;
#pragma unroll
  for (int ks = 0; ks < 4; ks++) {
    bf16x8 a = ld8(sVT + (32 * w + r) * 72 + ks * 16 + hh * 8);
#pragma unroll
    for (int ci = 0; ci < 4; ci++) acc[ci] = mfma32(a, ld8(sKT + (32 * ci + r) * 72 + ks * 16 + hh * 8), acc[ci]);
  }
  bf16_t* CT = (bf16_t*)(ws + OFF_MCT) + ((size_t)bh * 128 + c) * 16384;
#pragma unroll
  for (int ci = 0; ci < 4; ci++)
#pragma unroll
    for (int i = 0; i < 16; i++) {
      const int dv = 32 * w + (i & 3) + 8 * (i >> 2) + 4 * hh;
      CT[dv * 128 + 32 * ci + r] = f2bf(acc[ci][i]);
    }
}

DEVI void mlstm_carry(const Params& p, int task, char* smem) {
  char* ws = p.ws;
  const int tid = tidx();
  float* msc = (float*)(ws + OFF_MSC);
  float* sDecay = (float*)smem;
  float* sScale = sDecay + 128;
  const int bh = task / 9, seg = task % 9;
  float* sMl = sScale + 128;
  float* sBl = sMl + 128;
  __syncthreads();
  if (tid < 128) { sMl[tid] = msc[bh * 128 + tid]; sBl[tid] = msc[1024 + bh * 128 + tid]; }
  __syncthreads();
  if (tid == 0) {
    float mprev = 0.f;
    for (int c = 0; c < 128; c++) {
      const float mloc = sMl[c], blast = sBl[c];
      const float mnext = fmaxf(blast + mprev, mloc);
      sDecay[c] = expf(blast + mprev - mnext);
      sScale[c] = expf(mloc - mnext);
      sMl[c] = mprev;
      mprev = mnext;
    }
  }
  __syncthreads();
  if (seg == 0 && tid < 128) msc[2048 + bh * 128 + tid] = sMl[tid];
  if (seg < 8) {
    bf16_t* CT = (bf16_t*)(ws + OFF_MCT) + (size_t)bh * 128 * 16384 + (size_t)(seg * 256 + tid) * 8;
    float cs[8];
#pragma unroll
    for (int q = 0; q < 8; q++) cs[q] = 0.f;
#pragma unroll 1
    for (int c0 = 0; c0 < 128; c0 += 16) {
      u32x4 v[16];
#pragma unroll
      for (int j = 0; j < 16; j++) v[j] = *(const u32x4*)(CT + (size_t)(c0 + j) * 16384);
#pragma unroll
      for (int j = 0; j < 16; j++) {
        u32x4 o = {pack2(cs[0], cs[1]), pack2(cs[2], cs[3]), pack2(cs[4], cs[5]), pack2(cs[6], cs[7])};
        *(u32x4*)(CT + (size_t)(c0 + j) * 16384) = o;
        const float dc = sDecay[c0 + j], sc = sScale[c0 + j];
        cs[0] = dc * cs[0] + sc * lo2f(v[j][0]); cs[1] = dc * cs[1] + sc * hi2f(v[j][0]);
        cs[2] = dc * cs[2] + sc * lo2f(v[j][1]); cs[3] = dc * cs[3] + sc * hi2f(v[j][1]);
        cs[4] = dc * cs[4] + sc * lo2f(v[j][2]); cs[5] = dc * cs[5] + sc * hi2f(v[j][2]);
        cs[6] = dc * cs[6] + sc * lo2f(v[j][3]); cs[7] = dc * cs[7] + sc * hi2f(v[j][3]);
      }
    }
  } else if (tid < 128) {
    float* N = (float*)(ws + OFF_MN) + (size_t)bh * 128 * 128 + tid;
    float ns = 0.f;
#pragma unroll 1
    for (int c0 = 0; c0 < 128; c0 += 16) {
      float v[16];
#pragma unroll
      for (int j = 0; j < 16; j++) v[j] = N[(size_t)(c0 + j) * 128];
#pragma unroll
      for (int j = 0; j < 16; j++) {
        N[(size_t)(c0 + j) * 128] = ns;
        ns = sDecay[c0 + j] * ns + sScale[c0 + j] * v[j];
      }
    }
  }
}

DEVI void mlstm_out(const Params& p, int l, int task, char* smem) {
  char* ws = p.ws;
  const int tid = tidx(), lane = tid & 63, w = tid >> 6;
  const int c = task & 127, h = (task >> 7) & 3, b = task >> 9;
  const int bh = b * 4 + h;
  bf16_t* sQ = (bf16_t*)smem;
  bf16_t* sK = sQ + 64 * 136;
  bf16_t* sVT = sK + 64 * 136;
  float* sA = (float*)(smem + (2 * 64 * 136 + 128 * 72) * 2);
  float* sM = sA + 64;
  float* sBc = sM + 64;
  float* sN = sBc + 64;
  float* sPart = sN + 128;
  const float* small = (const float*)(ws + OFF_SMALL);
  const float* msc = (const float*)(ws + OFF_MSC);
  const float mprev = msc[2048 + bh * 128 + c];
  __syncthreads();
  if (w == 0) {
    const size_t row = (size_t)(b * SEQ + c * 64 + lane) * 16;
    const float ipre = small[row + h] + p.in[15][l * 4 + h];
    const float lf = logsigf(small[row + 4 + h] + p.in[16][l * 4 + h]);
    float bc = lf;
#pragma unroll
    for (int o = 1; o < 64; o <<= 1) {
      float v = __shfl_up(bc, o, 64);
      if (lane >= o) bc += v;
    }
    const float a = ipre - bc;
    float pm = a;
#pragma unroll
    for (int o = 1; o < 64; o <<= 1) {
      float v = __shfl_up(pm, o, 64);
      if (lane >= o) pm = fmaxf(pm, v);
    }
    sA[lane] = a;
    sM[lane] = fmaxf(mprev, pm);
    sBc[lane] = bc;
  }
  if (tid >= 128) sN[tid - 128] = ((const float*)(ws + OFF_MN))[((size_t)bh * 128 + c) * 128 + (tid - 128)];
  conv_tile<false>(p, l, b, c, h, 0, 1.f, nullptr, sQ);
  conv_tile<false>(p, l, b, c, h, 1, 0.08838834764831845f, nullptr, sK);
  vT_tile(p, b, c, h, sVT);
  __syncthreads();
  const int r = lane & 31, hh = lane >> 5;
  const int tt = w & 1, eh = w >> 1;
  const int tl = 32 * tt + r;
  const float Mt = sM[tl], bct = sBc[tl];
  const float mt = bct + Mt;
  const float interw = expf(mprev - Mt);
  float qn = 0.f;
  for (int d = 0; d < 64; d++) qn = fmaf(bf2f(sQ[tl * 136 + hh * 64 + d]), sN[hh * 64 + d], qn);
  qn += shx32(qn);
  f32x16 oacc[2];
#pragma unroll
  for (int ei = 0; ei < 2; ei++)
#pragma unroll
    for (int i = 0; i < 16; i++) oacc[ei][i] = 0.f;
  float den = 0.f;
  for (int si = 0; si <= tt; si++) {
    f32x16 sacc;
#pragma unroll
    for (int i = 0; i < 16; i++) sacc[i] = 0.f;
#pragma unroll
    for (int ks = 0; ks < 8; ks++)
      sacc = mfma32(ld8(sK + (32 * si + r) * 136 + ks * 16 + hh * 8), ld8(sQ + tl * 136 + ks * 16 + hh * 8), sacc);
    float pv[16];
#pragma unroll
    for (int i = 0; i < 16; i++) {
      const int s = 32 * si + (i & 3) + 8 * (i >> 2) + 4 * hh;
      const float v = (s <= tl) ? sacc[i] * expf(sA[s] - Mt) : 0.f;
      pv[i] = v;
      den += v;
    }
#pragma unroll
    for (int k2 = 0; k2 < 2; k2++) {
      bf16x8 pf;
#pragma unroll
      for (int j = 0; j < 8; j++) pf[j] = (short)f2bf(pv[8 * k2 + j]);
#pragma unroll
      for (int ei = 0; ei < 2; ei++) {
        const bf16_t* vp = sVT + (eh * 64 + ei * 32 + r) * 72 + 32 * si + 16 * k2 + 4 * hh;
        uint2 lo = *(const uint2*)vp, hi = *(const uint2*)(vp + 8);
        uint4 av = {lo.x, lo.y, hi.x, hi.y};
        oacc[ei] = mfma32(*(bf16x8*)&av, pf, oacc[ei]);
      }
    }
  }
  den += shx32(den);
  den += interw * qn;
  const bf16_t* CT = (const bf16_t*)(ws + OFF_MCT) + ((size_t)bh * 128 + c) * 16384;
  f32x16 cacc[2];
#pragma unroll
  for (int ei = 0; ei < 2; ei++)
#pragma unroll
    for (int i = 0; i < 16; i++) cacc[ei][i] = 0.f;
#pragma unroll
  for (int ks = 0; ks < 8; ks++) {
    bf16x8 qf = ld8(sQ + tl * 136 + ks * 16 + hh * 8);
#pragma unroll
    for (int ei = 0; ei < 2; ei++)
      cacc[ei] = mfma32(ld8(CT + (size_t)(eh * 64 + ei * 32 + r) * 128 + ks * 16 + hh * 8), qf, cacc[ei]);
  }
  const float dinv = 1.f / fmaxf(fabsf(den), expf(-mt));
  float ssq = 0.f;
#pragma unroll
  for (int ei = 0; ei < 2; ei++)
#pragma unroll
    for (int i = 0; i < 16; i++) {
      const float hv = (oacc[ei][i] + interw * cacc[ei][i]) * dinv;
      oacc[ei][i] = hv;
      ssq += hv * hv;
    }
  ssq += shx32(ssq);
  if (hh == 0) sPart[eh * 64 + tl] = ssq;
  __syncthreads();
  const float rs = rsqrtf((sPart[tl] + sPart[64 + tl]) * (1.f / 128.f) + EPS);
  const bf16_t* projb = (const bf16_t*)(ws + OFF_PROJ);
  bf16_t* ys = (bf16_t*)(ws + OFF_YS) + (size_t)1 * T * 512;
  const size_t tok = (size_t)(b * SEQ + c * 64 + tl);
#pragma unroll
  for (int ei = 0; ei < 2; ei++)
#pragma unroll
    for (int g = 0; g < 4; g++) {
      const int e = eh * 64 + ei * 32 + 8 * g + 4 * hh;
      const float4 gg = *(const float4*)(p.in[17] + l * 512 + h * 128 + e);
      const uint2 zz = *(const uint2*)(projb + tok * PJ + C_ZB + h * 128 + e);
      const float o0 = oacc[ei][4 * g] * rs * gg.x * siluf(lo2f(zz.x));
      const float o1 = oacc[ei][4 * g + 1] * rs * gg.y * siluf(hi2f(zz.x));
      const float o2 = oacc[ei][4 * g + 2] * rs * gg.z * siluf(lo2f(zz.y));
      const float o3 = oacc[ei][4 * g + 3] * rs * gg.w * siluf(hi2f(zz.y));
      uint2 pk = {pack2(o0, o1), pack2(o2, o3)};
      *(uint2*)(ys + tok * 512 + h * 128 + e) = pk;
    }
}

DEVI void qq_tile(const Params& p, int l, int id, char* smem) {
  char* ws = p.ws;
  const bf16_t* projb = (const bf16_t*)(ws + OFF_PROJ);
  const bf16_t* W = (const bf16_t*)(ws + OFF_WQ) + (size_t)l * 1024 * 256;
  bf16_t* qq = (bf16_t*)(ws + OFF_QQ);
  float* rsc = (float*)(smem + 2 * 128 * GLD * 2);
  const int mt = id >> 3, nt = id & 7;
  const int m0 = mt * 128, n0 = nt * 128;
  const int tid = tidx();
  __syncthreads();
  {
    const int row = tid >> 1, half = tid & 1;
    const bf16_t* cp = projb + (size_t)(m0 + row) * PJ + C_CQ + half * 128;
    float ss = 0.f;
#pragma unroll
    for (int i = 0; i < 16; i++) {
      uint4 v = *(const uint4*)(cp + i * 8);
      float f[8];
      unpack8(v, f);
#pragma unroll
      for (int q = 0; q < 8; q++) ss = fmaf(f[q], f[q], ss);
    }
    ss += __shfl_xor(ss, 1, 64);
    if (half == 0) rsc[row] = rsqrtf(ss * (1.f / 256.f) + EPS);
  }
  f32x16 acc[2][2];
  zero_acc<2>(acc);
  gemm_mainloop<2>(projb + (size_t)m0 * PJ + C_CQ, PJ, W + (size_t)n0 * 256, 256, 256, smem, acc);
  {
    bf16_t* sT = (bf16_t*)smem;
    __syncthreads();
    gemm_epilogue<2>(acc, [&](int ml, int nl, f32x4 v) {
      const float rs = rsc[ml];
      uint2 pk = {pack2(v[0] * rs, v[1] * rs), pack2(v[2] * rs, v[3] * rs)};
      *(uint2*)(sT + ml * 136 + nl) = pk;
    });
    __syncthreads();
#pragma unroll
    for (int j = 0; j < 8; j++) {
      const int c = tid + 256 * j;
      const int row = c >> 4, col = (c & 15) * 8;
      *(uint4*)(qq + (size_t)(m0 + row) * 1024 + n0 + col) = *(const uint4*)(sT + row * 136 + col);
    }
  }
}
DEVI void kiv_task(const Params& p, int l, int id, char* smem) {
  char* ws = p.ws;
  const bf16_t* projb = (const bf16_t*)(ws + OFF_PROJ);
  bf16_t* ki = (bf16_t*)(ws + OFF_KI);
  bf16_t* vT = (bf16_t*)(ws + OFF_VT);
  bf16_t* sT = (bf16_t*)smem;
  const int tid = tidx();
  const int tok0 = id * 64;
  const int b = tok0 / SEQ, s0 = tok0 % SEQ;
  __syncthreads();
  {
    const int tk = tid >> 2, qd = tid & 3;
    const bf16_t* kp = projb + (size_t)(tok0 + tk) * PJ + C_KIDX + qd * 16;
    float f[16];
    unpack8(*(const uint4*)kp, f);
    unpack8(*(const uint4*)(kp + 8), f + 8);
    float mu = 0.f;
#pragma unroll
    for (int i = 0; i < 16; i++) mu += f[i];
    mu += __shfl_xor(mu, 1, 64);
    mu += __shfl_xor(mu, 2, 64);
    mu *= (1.f / 64.f);
    float var = 0.f;
#pragma unroll
    for (int i = 0; i < 16; i++) { f[i] -= mu; var = fmaf(f[i], f[i], var); }
    var += __shfl_xor(var, 1, 64);
    var += __shfl_xor(var, 2, 64);
    const float rs = rsqrtf(var * (1.f / 64.f) + EPS);
    const float* g = p.in[21] + l * 64 + qd * 16;
    const float* bb = p.in[22] + l * 64 + qd * 16;
    float o[16];
#pragma unroll
    for (int i = 0; i < 16; i++) o[i] = f[i] * rs * g[i] + bb[i];
    uint4 o0 = {pack2(o[0], o[1]), pack2(o[2], o[3]), pack2(o[4], o[5]), pack2(o[6], o[7])};
    uint4 o1 = {pack2(o[8], o[9]), pack2(o[10], o[11]), pack2(o[12], o[13]), pack2(o[14], o[15])};
    *(uint4*)(ki + (size_t)(tok0 + tk) * 64 + qd * 16) = o0;
    *(uint4*)(ki + (size_t)(tok0 + tk) * 64 + qd * 16 + 8) = o1;
  }
  {
    const int tk = tid >> 2, part = tid & 3;
    const bf16_t* kp = projb + (size_t)(tok0 + tk) * PJ + C_KC + part * 32;
    float ss = 0.f;
#pragma unroll
    for (int k = 0; k < 4; k++) {
      float f[8];
      unpack8(*(const uint4*)(kp + 8 * k), f);
#pragma unroll
      for (int q = 0; q < 8; q++) ss = fmaf(f[q], f[q], ss);
    }
#pragma unroll
    for (int o = 1; o < 64; o <<= 1) ss = (o < 4) ? ss + __shfl_xor(ss, o, 64) : fmaxf(ss, __shfl_xor(ss, o, 64));
    if ((tid & 63) == 0) {
      unsigned* km = (unsigned*)(ws + OFF_KMAX) + l * 2 + b;
      const unsigned bits = __float_as_uint(ss);
      if (bits > __hip_atomic_load(km, __ATOMIC_RELAXED, __HIP_MEMORY_SCOPE_AGENT)) atomicMax(km, bits);
    }
  }
#pragma unroll
  for (int i = 0; i < 4; i++) {
    const int e = tid + 256 * i;
    const int tt = e >> 4, d8 = (e & 15) * 8;
    uint4 xv = *(const uint4*)(projb + (size_t)(tok0 + tt) * PJ + C_VC + d8);
    sT[(d8 + 0) * 72 + tt] = (bf16_t)(xv.x & 0xffffu);
    sT[(d8 + 1) * 72 + tt] = (bf16_t)(xv.x >> 16);
    sT[(d8 + 2) * 72 + tt] = (bf16_t)(xv.y & 0xffffu);
    sT[(d8 + 3) * 72 + tt] = (bf16_t)(xv.y >> 16);
    sT[(d8 + 4) * 72 + tt] = (bf16_t)(xv.z & 0xffffu);
    sT[(d8 + 5) * 72 + tt] = (bf16_t)(xv.z >> 16);
    sT[(d8 + 6) * 72 + tt] = (bf16_t)(xv.w & 0xffffu);
    sT[(d8 + 7) * 72 + tt] = (bf16_t)(xv.w >> 16);
  }
  __syncthreads();
#pragma unroll
  for (int i = 0; i < 4; i++) {
    const int e = tid + 256 * i;
    const int d = e >> 3, c8 = (e & 7) * 8;
    *(uint4*)(vT + ((size_t)b * 128 + d) * SEQ + s0 + c8) = *(const uint4*)(sT + d * 72 + c8);
  }
}

constexpr int QLD = 584;
DEVI void load_kf(bf16x8 (&kf)[4], const bf16_t* __restrict__ kib, int s0, int i, int q4) {
#pragma unroll
  for (int kt = 0; kt < 2; kt++)
#pragma unroll
    for (int kq = 0; kq < 2; kq++) kf[kt * 2 + kq] = ld8(kib + (size_t)(s0 + 16 * kt + i) * 64 + 32 * kq + 8 * q4);
}
DEVI void score_tile(const bf16x8 (&kf)[4], const bf16x8 (&qr)[18], const float (&wh)[8], f32x4& sc0, f32x4& sc1) {
  sc0 = {0.f, 0.f, 0.f, 0.f};
  sc1 = {0.f, 0.f, 0.f, 0.f};
  sc0 = mfma16(kf[0], qr[16], sc0);
  sc0 = mfma16(kf[1], qr[17], sc0);
  sc1 = mfma16(kf[2], qr[16], sc1);
  sc1 = mfma16(kf[3], qr[17], sc1);
#pragma unroll
  for (int h = 0; h < 8; h++) {
    f32x4 d0 = {0.f, 0.f, 0.f, 0.f}, d1 = {0.f, 0.f, 0.f, 0.f};
    d0 = mfma16(kf[0], qr[2 * h], d0);
    d0 = mfma16(kf[1], qr[2 * h + 1], d0);
    d1 = mfma16(kf[2], qr[2 * h], d1);
    d1 = mfma16(kf[3], qr[2 * h + 1], d1);
#pragma unroll
    for (int rg = 0; rg < 4; rg++) {
      sc0[rg] = fmaf(fabsf(d0[rg]), wh[h], sc0[rg]);
      sc1[rg] = fmaf(fabsf(d1[rg]), wh[h], sc1[rg]);
    }
  }
}
DEVI unsigned monokey(float f) {
  unsigned u = __float_as_uint(f);
  return (u & 0x80000000u) ? ~u : (u | 0x80000000u);
}

constexpr int DSA_OFF_STAGE = 16 * QLD * 2;
constexpr int KLD = 136, VLD = 72;
constexpr int DSA_STAGE_BYTES = 64 * KLD * 2 + 128 * VLD * 2;
constexpr int DSA_OFF_HIST = DSA_OFF_STAGE;
constexpr int DSA_OFF_CODE = DSA_OFF_HIST + 16 * 129 * 4;
constexpr int DSA_OFF_SEGS = DSA_OFF_CODE + 16 * 129 * 4;
constexpr int DSA_OFF_MASKA = DSA_OFF_STAGE + 18048;
static_assert(DSA_OFF_SEGS + 176 * 4 <= DSA_OFF_MASKA, "layout");
static_assert(DSA_OFF_MASKA + 16384 <= DSA_OFF_STAGE + DSA_STAGE_BYTES, "layout");
constexpr int DSA_OFF_WQ = DSA_OFF_STAGE + DSA_STAGE_BYTES;
constexpr int DSA_OFF_MISC = DSA_OFF_WQ + 512;
static_assert(DSA_OFF_MISC + 256 <= SMEM_BYTES, "LDS overflow");
constexpr int QB = 16;

DEVI void dsa_task(const Params& p, int l, int b, int t0, char* smem) {
  char* ws = p.ws;
  bf16_t* sQI = (bf16_t*)smem;
  unsigned char* maskF = (unsigned char*)smem;
  unsigned* hist = (unsigned*)(smem + DSA_OFF_HIST);
  unsigned* code = (unsigned*)(smem + DSA_OFF_CODE);
  unsigned* segs = (unsigned*)(smem + DSA_OFF_SEGS);
  unsigned* pref = segs + 128;
  int* krem = (int*)(pref + 16);
  unsigned* thr = (unsigned*)(krem + 16);
  unsigned char* maskA = (unsigned char*)(smem + DSA_OFF_MASKA);
  unsigned* maskAw = (unsigned*)(smem + DSA_OFF_MASKA);
  bf16_t* sK = (bf16_t*)(smem + DSA_OFF_STAGE);
  bf16_t* sVT = sK + 64 * KLD;
  float* sWq = (float*)(smem + DSA_OFF_WQ);
  int* cnt = (int*)(smem + DSA_OFF_MISC);
  int* ovf = cnt + 32;
  const int tid = tidx(), lane = tid & 63, w = tid >> 6;
  const int i = lane & 15, q4 = lane >> 4;
  const bf16_t* qq = (const bf16_t*)(ws + OFF_QQ);
  const bf16_t* projb = (const bf16_t*)(ws + OFF_PROJ);
  const bf16_t* kib = (const bf16_t*)(ws + OFF_KI) + (size_t)b * SEQ * 64;
  const bf16_t* vT = (const bf16_t*)(ws + OFF_VT) + (size_t)b * 128 * SEQ;
  const float* small = (const float*)(ws + OFF_SMALL);
  const int n_it = (t0 + QB + 127) >> 7;
  const int tq = t0 + i;
  const int tlast = t0 + QB - 1;
  const bool need_sel = (tlast > 255);
  __syncthreads();
  if (tid < 16) { thr[tid] = 0u; pref[tid] = 0u; krem[tid] = 256; cnt[tid] = 0; }
  if (tid == 0) *ovf = 0;
  for (int k = tid; k < 16 * 129; k += 256) hist[k] = 0u;
  {
    uint4 z = {0u, 0u, 0u, 0u};
#pragma unroll
    for (int k = 0; k < 4; k++) *(uint4*)(maskA + (tid * 4 + k) * 16) = z;
  }
  __syncthreads();
  if (need_sel) {
    bf16x8 qr[18];
    float wh[8];
    {
      const bf16_t* qrow = qq + (size_t)(b * SEQ + t0 + i) * 1024 + 512 + 8 * q4;
#pragma unroll
      for (int h = 0; h < 8; h++) { qr[2 * h] = ld8(qrow + h * 64); qr[2 * h + 1] = ld8(qrow + h * 64 + 32); }
      const float4 w0 = *(const float4*)(small + (size_t)(b * SEQ + t0 + i) * 16 + 8);
      const float4 w1 = *(const float4*)(small + (size_t)(b * SEQ + t0 + i) * 16 + 12);
      const float sc = 0.5f * 0.044194173824159216f;
      wh[0] = w0.x * sc; wh[1] = w0.y * sc; wh[2] = w0.z * sc; wh[3] = w0.w * sc;
      wh[4] = w1.x * sc; wh[5] = w1.y * sc; wh[6] = w1.z * sc; wh[7] = w1.w * sc;
#pragma unroll
      for (int kq = 0; kq < 2; kq++) {
        float a[8];
#pragma unroll
        for (int j = 0; j < 8; j++) a[j] = 0.f;
#pragma unroll
        for (int h = 0; h < 8; h++) {
#pragma unroll
          for (int j = 0; j < 8; j++) a[j] = fmaf(wh[h], bf2f((bf16_t)qr[2 * h + kq][j]), a[j]);
        }
        bf16x8 o;
#pragma unroll
        for (int j = 0; j < 8; j++) o[j] = (short)f2bf(a[j]);
        qr[16 + kq] = o;
      }
    }
#pragma unroll 1
    for (int pass = 0; pass < 5; pass++) {
      const int shift = 24 - 8 * pass;
      const unsigned pf = pref[i];
      const bool collect = (pass == 2) && (*ovf == 0);
      const bool maskthr = (pass == 4);
      const unsigned thr_i = thr[i];
      bf16x8 kf[4], kn[4], kn2[4];
      load_kf(kf, kib, w * 32, i, q4);
      if (w * 32 + 128 <= tlast) load_kf(kn, kib, w * 32 + 128, i, q4);
#pragma unroll 1
      for (int it = 0; it < n_it; it++) {
        const int s0 = it * 128 + w * 32;
        const bool valid = (s0 <= tlast);
        if (s0 + 256 <= tlast) load_kf(kn2, kib, s0 + 256, i, q4);
        if (valid) {
          f32x4 sc0, sc1;
          score_tile(kf, qr, wh, sc0, sc1);
          unsigned bits = 0u;
#pragma unroll
          for (int e = 0; e < 8; e++) {
            const int s = s0 + 16 * (e >> 2) + 4 * q4 + (e & 3);
            const unsigned key = monokey((e < 4) ? sc0[e & 3] : sc1[e & 3]);
            if (s <= tq) {
              if (collect) {
                const unsigned k16 = key >> 16;
                if (k16 > pf) bits |= (1u << e);
                else if (k16 == pf) {
                  const int idx = atomicAdd(&cnt[i], 1);
                  if (idx < 128) { hist[i * 129 + idx] = key; code[i * 129 + idx] = ((unsigned)((it * 4 + w) * 64 + lane) << 3) | (unsigned)e; }
                }
              } else if (maskthr) {
                if (key >= thr_i) bits |= (1u << e);
              } else if (pass == 0 || ((key >> (shift + 8)) == pf)) {
                const unsigned bin = (key >> shift) & 255u;
                atomicAdd(&hist[i * 129 + (bin >> 1)], 1u << ((bin & 1u) * 16));
              }
            }
          }
          if (collect || maskthr) maskA[(it * 4 + w) * 64 + lane] = (unsigned char)bits;
        }
#pragma unroll
        for (int ks = 0; ks < 4; ks++) { kf[ks] = kn[ks]; kn[ks] = kn2[ks]; }
      }
      __syncthreads();
      if (maskthr) break;
      if (collect) {
        if (tid < 128) {
          const int q = tid >> 3, j = tid & 7;
          const int nraw = cnt[q];
          const int n = nraw < 128 ? nraw : 128;
          const int kr = krem[q];
          if (nraw > 128) *ovf = 1;
          for (int e = j; e < n; e += 8) {
            const unsigned ke = hist[q * 129 + e];
            int g = 0, ge = 0;
            for (int f = 0; f < n; f++) {
              const unsigned kf2 = hist[q * 129 + f];
              g += (kf2 > ke) ? 1 : 0;
              ge += (kf2 >= ke) ? 1 : 0;
            }
            if (g < kr && ge >= kr) thr[q] = ke;
          }
        }
        __syncthreads();
        if (*ovf == 0) {
          if (tid < 128) {
            const int q = tid >> 3, j = tid & 7;
            const int n = cnt[q];
            const unsigned tq2 = thr[q];
            for (int e = j; e < n; e += 8) {
              if (hist[q * 129 + e] >= tq2) {
                const unsigned cd = code[q * 129 + e];
                const unsigned byte = cd >> 3, bit = cd & 7u;
                atomicOr(&maskAw[byte >> 2], 1u << ((byte & 3u) * 8 + bit));
              }
            }
          }
          __syncthreads();
          break;
        }
        for (int k = tid; k < 16 * 129; k += 256) hist[k] = 0u;
        __syncthreads();
        pass--;
        continue;
      }
      if (tid < 128) {
        const int q = tid >> 3, j = tid & 7;
        unsigned ssum = 0;
#pragma unroll
        for (int k = 0; k < 16; k++) {
          const unsigned wv = hist[q * 129 + 16 * j + k];
          ssum += (wv & 0xffffu) + (wv >> 16);
        }
        segs[q * 8 + j] = ssum;
      }
      __syncthreads();
      if (tid < 16) {
        const int q = tid;
        const int kr = krem[q];
        int cum = 0, j = 7;
        while (j > 0 && cum + (int)segs[q * 8 + j] < kr) { cum += (int)segs[q * 8 + j]; j--; }
        int bin = 32 * j + 31;
        while (bin > 32 * j) {
          const unsigned wv = hist[q * 129 + (bin >> 1)];
          const int c2 = (bin & 1) ? (int)(wv >> 16) : (int)(wv & 0xffffu);
          if (cum + c2 >= kr) break;
          cum += c2;
          bin--;
        }
        pref[q] = (pref[q] << 8) | (unsigned)bin;
        krem[q] = kr - cum;
        if (pass == 3) thr[q] = pref[q];
      }
      __syncthreads();
      for (int k = tid; k < 16 * 129; k += 256) hist[k] = 0u;
      __syncthreads();
    }
  } else {
    for (int it = 0; it < n_it; it++) {
      const int s0 = it * 128 + w * 32;
      unsigned bits = 0u;
#pragma unroll
      for (int e = 0; e < 8; e++) {
        const int s = s0 + 16 * (e >> 2) + 4 * q4 + (e & 3);
        if (s <= tq) bits |= (1u << e);
      }
      maskA[(it * 4 + w) * 64 + lane] = (unsigned char)bits;
    }
    __syncthreads();
  }
  {
    uint4 mv[4];
#pragma unroll
    for (int k = 0; k < 4; k++) mv[k] = *(const uint4*)(maskA + (tid * 4 + k) * 16);
#pragma unroll
    for (int k = 0; k < 4; k++) *(uint4*)(maskF + (tid * 4 + k) * 16) = mv[k];
  }
  __syncthreads();
  const int hp = w >> 1, hf = w & 1;
  bf16x8 qf[2][4];
#pragma unroll
  for (int hd = 0; hd < 2; hd++)
#pragma unroll
    for (int kq = 0; kq < 4; kq++)
      qf[hd][kq] = ld8(qq + (size_t)(b * SEQ + t0 + i) * 1024 + (2 * hp + hd) * 128 + 32 * kq + 8 * q4);
  f32x4 O[2][8];
#pragma unroll
  for (int hd = 0; hd < 2; hd++)
#pragma unroll
    for (int dt = 0; dt < 8; dt++) O[hd][dt] = {0.f, 0.f, 0.f, 0.f};
  float l_run[2] = {0.f, 0.f};
  const float scale = 0.08838834764831845f;
  float m_ref[2];
  {
    const float kmax2 = __uint_as_float(__hip_atomic_load((const unsigned*)(ws + OFF_KMAX) + l * 2 + b, __ATOMIC_RELAXED, __HIP_MEMORY_SCOPE_AGENT));
#pragma unroll
    for (int hd = 0; hd < 2; hd++) {
      float qn = 0.f;
#pragma unroll
      for (int kq = 0; kq < 4; kq++)
#pragma unroll
        for (int j = 0; j < 8; j++) { const float v = bf2f((bf16_t)qf[hd][kq][j]); qn = fmaf(v, v, qn); }
      qn += __shfl_xor(qn, 16, 64);
      qn += __shfl_xor(qn, 32, 64);
      m_ref[hd] = fminf(sqrtf(qn * kmax2) * scale, 40.f);
    }
  }
  const int krow = tid >> 2, kcol = (tid & 3) * 32;
  const int vrow = tid >> 1, vcol = (tid & 1) * 32;
  const bf16_t* kg = projb + (size_t)(b * SEQ + krow) * PJ + C_KC + kcol;
  const bf16_t* vg = vT + (size_t)vrow * SEQ + vcol;
  u32x4 pk[4], pvr[4];
#pragma unroll
  for (int k = 0; k < 4; k++) { pk[k] = *(const u32x4*)(kg + 8 * k); pvr[k] = *(const u32x4*)(vg + 8 * k); }
#pragma unroll 1
  for (int ss0 = 0; ss0 <= tlast; ss0 += 64) {
    __syncthreads();
#pragma unroll
    for (int k = 0; k < 4; k++) {
      *(u32x4*)(sK + krow * KLD + kcol + 8 * k) = pk[k];
      *(u32x4*)(sVT + vrow * VLD + vcol + 8 * k) = pvr[k];
    }
    __syncthreads();
    if (ss0 + 64 <= tlast) {
      const bf16_t* kg2 = kg + (size_t)(ss0 + 64) * PJ;
      const bf16_t* vg2 = vg + ss0 + 64;
#pragma unroll
      for (int k = 0; k < 4; k++) { pk[k] = *(const u32x4*)(kg2 + 8 * k); pvr[k] = *(const u32x4*)(vg2 + 8 * k); }
    }
    const unsigned mb = (unsigned)maskF[((ss0 >> 5) + hf) * 64 + lane];
    if (__ballot(mb != 0u) == 0ull) continue;
    f32x4 sa[2][2];
#pragma unroll
    for (int hd = 0; hd < 2; hd++)
#pragma unroll
      for (int kt = 0; kt < 2; kt++) sa[hd][kt] = {0.f, 0.f, 0.f, 0.f};
#pragma unroll
    for (int kq = 0; kq < 4; kq++)
#pragma unroll
      for (int kt = 0; kt < 2; kt++) {
        const bf16x8 kfr = ld8(sK + (32 * hf + 16 * kt + i) * KLD + 32 * kq + 8 * q4);
        sa[0][kt] = mfma16(kfr, qf[0][kq], sa[0][kt]);
        sa[1][kt] = mfma16(kfr, qf[1][kq], sa[1][kt]);
      }
    bf16x8 pf[2];
#pragma unroll
    for (int hd = 0; hd < 2; hd++) {
      float lsum = 0.f;
#pragma unroll
      for (int e = 0; e < 8; e++) {
        const float pe = ((mb >> e) & 1u) ? __expf(fmaf(sa[hd][e >> 2][e & 3], scale, -m_ref[hd])) : 0.f;
        pf[hd][e] = (short)f2bf(pe);
        lsum += pe;
      }
      l_run[hd] += lsum;
    }
#pragma unroll
    for (int dt = 0; dt < 8; dt++) {
      const bf16_t* vp = sVT + (16 * dt + i) * VLD + 32 * hf + 4 * q4;
      uint2 lo = *(const uint2*)vp, hi = *(const uint2*)(vp + 16);
      uint4 av = {lo.x, lo.y, hi.x, hi.y};
      O[0][dt] = mfma16(*(bf16x8*)&av, pf[0], O[0][dt]);
      O[1][dt] = mfma16(*(bf16x8*)&av, pf[1], O[1][dt]);
    }
  }
  __syncthreads();
#pragma unroll
  for (int hd = 0; hd < 2; hd++) {
    l_run[hd] += __shfl_xor(l_run[hd], 16, 64);
    l_run[hd] += __shfl_xor(l_run[hd], 32, 64);
  }
  float* mO = (float*)(smem + DSA_OFF_STAGE);
  float* mML = mO + 2 * 2 * 8 * 64 * 4;
  if (hf == 1) {
#pragma unroll
    for (int hd = 0; hd < 2; hd++) {
#pragma unroll
      for (int dt = 0; dt < 8; dt++) *(f32x4*)(mO + ((((hp * 2 + hd) * 8 + dt) * 64 + lane) << 2)) = O[hd][dt];
      mML[(hp * 2 + hd) * 64 + lane] = l_run[hd];
    }
  }
  __syncthreads();
  if (hf == 0) {
    bf16_t* ys = (bf16_t*)(ws + OFF_YS) + (size_t)2 * T * 512;
    const size_t tok = (size_t)(b * SEQ + t0 + i);
#pragma unroll
    for (int hd = 0; hd < 2; hd++) {
      const float linv = 1.f / (l_run[hd] + mML[(hp * 2 + hd) * 64 + lane]);
      const int head = 2 * hp + hd;
#pragma unroll
      for (int dt = 0; dt < 8; dt++) {
        const f32x4 o1 = *(const f32x4*)(mO + ((((hp * 2 + hd) * 8 + dt) * 64 + lane) << 2));
        const int d = 16 * dt + 4 * q4;
        const uint2 zz = *(const uint2*)(projb + tok * PJ + C_ZC + head * 128 + d);
        const float o0 = (O[hd][dt][0] + o1[0]) * linv * siluf(lo2f(zz.x));
        const float o1v = (O[hd][dt][1] + o1[1]) * linv * siluf(hi2f(zz.x));
        const float o2 = (O[hd][dt][2] + o1[2]) * linv * siluf(lo2f(zz.y));
        const float o3 = (O[hd][dt][3] + o1[3]) * linv * siluf(hi2f(zz.y));
        uint2 pk2 = {pack2(o0, o1v), pack2(o2, o3)};
        *(uint2*)(ys + tok * 512 + head * 128 + d) = pk2;
      }
    }
  }
}

DEVI void phaseE(const Params& p, int l, char* smem) {
  char* ws = p.ws;
  const bf16_t* yg = (const bf16_t*)(ws + OFF_YG);
  const bf16_t* W = (const bf16_t*)(ws + OFF_WGLU) + (size_t)l * 512 * 512;
  const bf16_t* projb = (const bf16_t*)(ws + OFF_PROJ);
  bf16_t* ys = (bf16_t*)(ws + OFF_YS);
  for (int id = blockIdx.x; id < 128 * 4; id += gridDim.x) {
    const int m0 = (id >> 2) * 128, n0 = (id & 3) * 128;
    f32x16 acc[2][2];
    zero_acc<2>(acc);
    gemm_mainloop<2>(yg + (size_t)m0 * 512, 512, W + (size_t)n0 * 512, 512, 512, smem, acc);
    gemm_epilogue<2>(acc, [&](int ml, int nl, f32x4 v) {
      const size_t m = m0 + ml;
      const int n = n0 + nl;
      const float4 gb = *(const float4*)(p.in[12] + l * 512 + n);
      const uint2 gg = *(const uint2*)(yg + m * 512 + n);
      const uint2 zz = *(const uint2*)(projb + m * PJ + C_ZA + n);
      const float o0 = lo2f(gg.x) * sigmf(v[0] + gb.x) * siluf(lo2f(zz.x));
      const float o1 = hi2f(gg.x) * sigmf(v[1] + gb.y) * siluf(hi2f(zz.x));
      const float o2 = lo2f(gg.y) * sigmf(v[2] + gb.z) * siluf(lo2f(zz.y));
      const float o3 = hi2f(gg.y) * sigmf(v[3] + gb.w) * siluf(hi2f(zz.y));
      uint2 pk = {pack2(o0, o1), pack2(o2, o3)};
      *(uint2*)(ys + m * 512 + n) = pk;
    });
  }
}

DEVI void phaseF(const Params& p, int l, char* smem) {
  char* ws = p.ws;
  const bf16_t* Wb = (const bf16_t*)(ws + OFF_WBR) + (size_t)l * 3 * 1024 * 512;
  const bf16_t* ys = (const bf16_t*)(ws + OFF_YS);
  const unsigned char* gates = (const unsigned char*)(ws + OFF_GATES);
  bf16_t* merged = (bf16_t*)(ws + OFF_QQ);
  const int lane = tidx() & 63, w = tidx() >> 6;
  const int r = lane & 31, hh = lane >> 5, wm = w & 1, wn = w >> 1;
  for (int id = blockIdx.x; id < 128 * 8; id += gridDim.x) {
    const int m0 = (id >> 3) * 128, n0 = (id & 7) * 128;
    f32x16 mg[2][2];
    zero_acc<2>(mg);
#pragma unroll 1
    for (int n = 0; n < 3; n++) {
      f32x16 acc[2][2];
      zero_acc<2>(acc);
      gemm_mainloop<2>(ys + (size_t)n * T * 512 + (size_t)m0 * 512, 512, Wb + (size_t)(n * 1024 + n0) * 512, 512, 512, smem, acc);
      unsigned char* sG = (unsigned char*)smem;
      __syncthreads();
      {
        const int tid = tidx();
#pragma unroll
        for (int j = 0; j < 4; j++) {
          const int c = tid + 256 * j;
          const int row = c >> 3, col = (c & 7) * 16;
          *(uint4*)(sG + row * 144 + col) = *(const uint4*)(gates + (size_t)(m0 + row) * 3072 + n * 1024 + n0 + col);
        }
      }
      __syncthreads();
#pragma unroll
      for (int ni = 0; ni < 2; ni++)
#pragma unroll
        for (int mi = 0; mi < 2; mi++)
#pragma unroll
          for (int g = 0; g < 4; g++) {
            const int ml = wm * 64 + mi * 32 + r;
            const int nl = wn * 64 + ni * 32 + 8 * g + 4 * hh;
            const unsigned gv = *(const unsigned*)(sG + ml * 144 + nl);
            const float k255 = 1.f / 255.f;
            mg[ni][mi][4 * g + 0] = fmaf((float)(gv & 255u) * k255, acc[ni][mi][4 * g + 0], mg[ni][mi][4 * g + 0]);
            mg[ni][mi][4 * g + 1] = fmaf((float)((gv >> 8) & 255u) * k255, acc[ni][mi][4 * g + 1], mg[ni][mi][4 * g + 1]);
            mg[ni][mi][4 * g + 2] = fmaf((float)((gv >> 16) & 255u) * k255, acc[ni][mi][4 * g + 2], mg[ni][mi][4 * g + 2]);
            mg[ni][mi][4 * g + 3] = fmaf((float)(gv >> 24) * k255, acc[ni][mi][4 * g + 3], mg[ni][mi][4 * g + 3]);
          }
    }
    {
      bf16_t* sT = (bf16_t*)smem;
      __syncthreads();
      gemm_epilogue<2>(mg, [&](int ml, int nl, f32x4 v) {
        uint2 pk = {pack2(v[0], v[1]), pack2(v[2], v[3])};
        *(uint2*)(sT + ml * 136 + nl) = pk;
      });
      __syncthreads();
      const int tid = tidx();
#pragma unroll
      for (int j = 0; j < 8; j++) {
        const int c = tid + 256 * j;
        const int row = c >> 4, col = (c & 15) * 8;
        *(uint4*)(merged + (size_t)(m0 + row) * 1024 + n0 + col) = *(const uint4*)(sT + row * 136 + col);
      }
    }
  }
}

DEVI void phaseG(const Params& p, int l, char* smem) {
  char* ws = p.ws;
  const bf16_t* merged = (const bf16_t*)(ws + OFF_QQ);
  const bf16_t* W = (const bf16_t*)(ws + OFF_WOUT) + (size_t)l * 1024 * 1024;
  bf16_t* xb = (bf16_t*)(ws + OFF_XB);
  float* rowsq = (float*)(ws + OFF_ROWSQ);
  float* sSq = (float*)(smem + 2 * 128 * GLD * 2);
  const int lane = tidx() & 63, w = tidx() >> 6;
  const int r = lane & 31, hh = lane >> 5, wm = w & 1, wn = w >> 1;
  for (int id = blockIdx.x; id < 128 * 8; id += gridDim.x) {
    const int m0 = (id >> 3) * 128, nt = id & 7, n0 = nt * 128;
    f32x16 acc[2][2];
    zero_acc<2>(acc);
    gemm_mainloop<2>(merged + (size_t)m0 * 1024, 1024, W + (size_t)n0 * 1024, 1024, 1024, smem, acc);
    float sq[2] = {0.f, 0.f};
#pragma unroll
    for (int ni = 0; ni < 2; ni++)
#pragma unroll
      for (int mi = 0; mi < 2; mi++)
#pragma unroll
        for (int g = 0; g < 4; g++) {
          const size_t m = m0 + wm * 64 + mi * 32 + r;
          const int n = n0 + wn * 64 + ni * 32 + 8 * g + 4 * hh;
          float4 xo = *(const float4*)(p.out + m * 1024 + n);
          xo.x += acc[ni][mi][4 * g]; xo.y += acc[ni][mi][4 * g + 1];
          xo.z += acc[ni][mi][4 * g + 2]; xo.w += acc[ni][mi][4 * g + 3];
          *(float4*)(p.out + m * 1024 + n) = xo;
          uint2 pk = {pack2(xo.x, xo.y), pack2(xo.z, xo.w)};
          *(uint2*)(xb + m * 1024 + n) = pk;
          sq[mi] += xo.x * xo.x + xo.y * xo.y + xo.z * xo.z + xo.w * xo.w;
        }
    sq[0] += shx32(sq[0]);
    sq[1] += shx32(sq[1]);
    __syncthreads();
    if (hh == 0) {
      sSq[wn * 128 + wm * 64 + r] = sq[0];
      sSq[wn * 128 + wm * 64 + 32 + r] = sq[1];
    }
    __syncthreads();
    if (tidx() < 128) rowsq[(size_t)(m0 + tidx()) * 8 + nt] = sSq[tidx()] + sSq[128 + tidx()];
  }
}

DEVI void phase_final(const Params& p) {
  const float* rowsq = (const float*)(p.ws + OFF_ROWSQ);
  const int lane = tidx() & 63, w = tidx() >> 6;
  for (int row = blockIdx.x * 4 + w; row < T; row += gridDim.x * 4) {
    const float4 a = *(const float4*)(rowsq + (size_t)row * 8);
    const float4 b = *(const float4*)(rowsq + (size_t)row * 8 + 4);
    const float s = ((a.x + a.y) + (a.z + a.w)) + ((b.x + b.y) + (b.z + b.w));
    const float rs = rsqrtf(s * (1.f / 1024.f) + EPS);
#pragma unroll
    for (int i = 0; i < 4; i++) {
      float4 v = *(const float4*)(p.out + (size_t)row * 1024 + i * 256 + lane * 4);
      const float4 g = *(const float4*)(p.in[25] + i * 256 + lane * 4);
      v.x *= rs * g.x; v.y *= rs * g.y; v.z *= rs * g.z; v.w *= rs * g.w;
      *(float4*)(p.out + (size_t)row * 1024 + i * 256 + lane * 4) = v;
    }
  }
}


DEVI void gsync(cg::grid_group& grid) {
  __builtin_amdgcn_fence(__ATOMIC_RELEASE, "agent");
  asm volatile("s_waitcnt vmcnt(0)" ::: "memory");
  grid.sync();
  __builtin_amdgcn_fence(__ATOMIC_ACQUIRE, "agent");
  asm volatile("s_waitcnt vmcnt(0)" ::: "memory");
}
DEVI void gbar(unsigned* ctr, unsigned& epoch) {
  asm volatile("s_waitcnt vmcnt(0)" ::: "memory");
  __syncthreads();
  epoch += 8;
  if (tidx() == 0) {
    __builtin_amdgcn_fence(__ATOMIC_RELEASE, "agent");
    asm volatile("s_waitcnt vmcnt(0)" ::: "memory");
    const unsigned g = blockIdx.x & 7u;
    const unsigned per = (gridDim.x + 7u - g) >> 3;
    const unsigned old = __hip_atomic_fetch_add(ctr + 32 * (1 + g), 1u, __ATOMIC_RELAXED, __HIP_MEMORY_SCOPE_AGENT);
    if ((old + 1u) % per == 0u)
      __hip_atomic_fetch_add(ctr, 1u, __ATOMIC_RELAXED, __HIP_MEMORY_SCOPE_AGENT);
    while (__hip_atomic_load(ctr, __ATOMIC_RELAXED, __HIP_MEMORY_SCOPE_AGENT) < epoch) __builtin_amdgcn_s_sleep(2);
    __builtin_amdgcn_fence(__ATOMIC_ACQUIRE, "agent");
    asm volatile("s_waitcnt vmcnt(0)" ::: "memory");
  }
  __syncthreads();
}
__global__ void __launch_bounds__(256, 2) fwd_megakernel(Params p) {
  cg::grid_group grid = cg::this_grid();
  __shared__ __attribute__((aligned(16))) char smem[SMEM_BYTES];
  const int G = gridDim.x;
  unsigned* bar_ctr = (unsigned*)(p.ws + OFF_BAR);
  unsigned bar_epoch = 0;
  if (blockIdx.x == 0 && tidx() < 9) __hip_atomic_store(bar_ctr + 32 * tidx(), 0u, __ATOMIC_RELAXED, __HIP_MEMORY_SCOPE_AGENT);
  if (blockIdx.x == 0 && tidx() < 8) __hip_atomic_store((unsigned*)(p.ws + OFF_KMAX) + tidx(), 0u, __ATOMIC_RELAXED, __HIP_MEMORY_SCOPE_AGENT);
  phase0(p, smem);
  gsync(grid);
  for (int l = 0; l < DEPTH; l++) {
    phase1(p, l, smem);
    gbar(bar_ctr, bar_epoch);
    s5_chunk_tasks<0>(p, l, smem);
    gbar(bar_ctr, bar_epoch);
    for (int id = blockIdx.x; id < 1024; id += G) mlstm_local(p, l, id, smem);
    for (int id = blockIdx.x; id < 1024; id += G) qq_tile(p, l, id, smem);
    for (int id = blockIdx.x; id < T / 64; id += G) kiv_task(p, l, id, smem);
    gbar(bar_ctr, bar_epoch);
    for (int cid = blockIdx.x; cid < 88; cid += G) {
      if (cid < 72) mlstm_carry(p, cid, smem);
      else s5_carry(p, l, (cid - 72) * 256 + tidx());
    }
    gbar(bar_ctr, bar_epoch);
    for (int id = blockIdx.x; id < 512; id += G) {
#pragma unroll 1
      for (int k = 0; k < 2; k++) {
        const int rank = k ? (1023 - id) : id;
        const int b = rank & 1, qb = 511 - (rank >> 1);
        dsa_task(p, l, b, qb * QB, smem);
      }
    }
    for (int id = blockIdx.x; id < 1024; id += G) mlstm_out(p, l, id, smem);
    gbar(bar_ctr, bar_epoch);
    s5_chunk_tasks<1>(p, l, smem);
    gbar(bar_ctr, bar_epoch);
    phaseE(p, l, smem);
    gbar(bar_ctr, bar_epoch);
    phaseF(p, l, smem);
    gbar(bar_ctr, bar_epoch);
    phaseG(p, l, smem);
    gbar(bar_ctr, bar_epoch);
  }
  phase_final(p);
}

extern "C" void kernel_launch(void* const* d_in, const int* in_sizes, int n_in, void* d_out, int out_size, void* d_ws,
                              size_t ws_size, hipStream_t stream) {
  static int grid_blocks = 0;
  if (!grid_blocks) {
    int dev = 0, cus = 0, per_cu = 0;
    (void)hipGetDevice(&dev);
    (void)hipDeviceGetAttribute(&cus, hipDeviceAttributeMultiprocessorCount, dev);
    (void)hipOccupancyMaxActiveBlocksPerMultiprocessor(&per_cu, fwd_megakernel, 256, 0);
    if (per_cu > 2) per_cu = 2;
    if (per_cu < 1) per_cu = 1;
    grid_blocks = cus * per_cu;
  }
  if (ws_size < WS_TOTAL) {
    fprintf(stderr, "workspace too small: %zu < %zu\n", ws_size, (size_t)WS_TOTAL);
    return;
  }
  Params p{};
  for (int i = 0; i < 26; i++) p.in[i] = (const float*)d_in[i];
  p.out = (float*)d_out;
  p.ws = (char*)d_ws;
  void* args[] = {&p};
  hipError_t e = hipLaunchCooperativeKernel((void*)fwd_megakernel, dim3(grid_blocks), dim3(256), args, 0, stream);
  if (e != hipSuccess) fprintf(stderr, "cooperative launch failed: %s (grid %d)\n", hipGetErrorString(e), grid_blocks);
}
```

```cpp
#include <hip/hip_runtime.h>
#include <hip/hip_bf16.h>
#include <hip/hip_cooperative_groups.h>
#include <cstdio>
namespace cg = cooperative_groups;

#define DEVI __device__ __forceinline__
typedef unsigned short bf16_t;
typedef __attribute__((ext_vector_type(8))) short bf16x8;
typedef __attribute__((ext_vector_type(16))) float f32x16;
typedef __attribute__((ext_vector_type(4))) float f32x4;
typedef __attribute__((ext_vector_type(4))) unsigned u32x4;

constexpr int D = 1024, SEQ = 8192, NB = 2, T = NB * SEQ, DEPTH = 4;
constexpr int INW = 7248;
constexpr int N1 = 4224;
constexpr int NWIN = 7296;
constexpr int PJ = 4224;
constexpr int C_UA = 0, C_ZA = 512, C_QB = 1024, C_KB = 1536, C_VB = 2048, C_ZB = 2560, C_CQ = 3072,
              C_KC = 3328, C_VC = 3456, C_KIDX = 3584, C_ZC = 3648, C_SMALL = 4160;
constexpr float EPS = 1e-6f;

constexpr size_t SZ_WIN = (size_t)DEPTH * NWIN * 1024 * 2;
constexpr size_t SZ_WGLU = (size_t)DEPTH * 512 * 512 * 2;
constexpr size_t SZ_WQ = (size_t)DEPTH * 1024 * 256 * 2;
constexpr size_t SZ_WBR = (size_t)DEPTH * 3 * 1024 * 512 * 2;
constexpr size_t SZ_WOUT = (size_t)DEPTH * 1024 * 1024 * 2;
constexpr size_t OFF_WIN = 0;
constexpr size_t OFF_WGLU = OFF_WIN + SZ_WIN;
constexpr size_t OFF_WQ = OFF_WGLU + SZ_WGLU;
constexpr size_t OFF_WBR = OFF_WQ + SZ_WQ;
constexpr size_t OFF_WOUT = OFF_WBR + SZ_WBR;
constexpr size_t OFF_XB = OFF_WOUT + SZ_WOUT;
constexpr size_t OFF_ROWSQ = OFF_XB + (size_t)T * 1024 * 2;
constexpr size_t OFF_PROJ = OFF_ROWSQ + (size_t)T * 8 * 4;
constexpr size_t OFF_SMALL = OFF_PROJ + (size_t)T * PJ * 2;
constexpr size_t OFF_QQ = OFF_SMALL + (size_t)T * 16 * 4;
constexpr size_t OFF_KI = OFF_QQ + (size_t)T * 1024 * 2;
constexpr size_t OFF_VT = OFF_KI + (size_t)T * 64 * 2;
constexpr size_t OFF_S5ST = OFF_VT + (size_t)NB * 128 * SEQ * 2;
constexpr size_t OFF_MCT = OFF_S5ST + (size_t)NB * 32 * 128 * 64 * 8;
constexpr size_t OFF_MN = OFF_MCT + (size_t)8 * 128 * 128 * 128 * 2;
constexpr size_t OFF_MSC = OFF_MN + (size_t)8 * 128 * 128 * 4;
constexpr size_t OFF_YG = OFF_MSC + (size_t)3 * 8 * 128 * 4;
constexpr size_t OFF_YS = OFF_YG + (size_t)T * 512 * 2;
constexpr size_t OFF_BAR = OFF_YS + (size_t)3 * T * 512 * 2;
constexpr size_t OFF_GATES = OFF_BAR + 2048;
constexpr size_t OFF_KMAX = OFF_GATES + (size_t)T * 3072;
constexpr size_t WS_TOTAL = OFF_KMAX + 256;

constexpr int SMEM_BYTES = 59392;

struct Params {
  const float* in[26];
  float* out;
  char* ws;
};

DEVI int tidx() { int t = threadIdx.x; asm volatile("" : "+v"(t)); return t; }
typedef float f32x2_t __attribute__((ext_vector_type(2)));
typedef __bf16 bf16x2_t __attribute__((ext_vector_type(2)));
DEVI bf16_t f2bf(float f) {
  __bf16 h = (__bf16)f;
  return __builtin_bit_cast(unsigned short, h);
}
DEVI float bf2f(bf16_t h) { return __uint_as_float(((unsigned)h) << 16); }
DEVI unsigned pack2(float a, float b) {
  f32x2_t v = {a, b};
  bf16x2_t h = __builtin_convertvector(v, bf16x2_t);
  return __builtin_bit_cast(unsigned, h);
}
DEVI float lo2f(unsigned u) { return __uint_as_float(u << 16); }
DEVI float hi2f(unsigned u) { return __uint_as_float(u & 0xffff0000u); }
DEVI float sigmf(float x) { return __builtin_amdgcn_rcpf(1.f + __expf(-x)); }
DEVI float siluf(float x) { return x * sigmf(x); }
DEVI float geluf(float x) {
  float u = 0.7978845608028654f * (x + 0.044715f * x * x * x);
  return x * sigmf(2.f * u);
}
DEVI f32x16 mfma32(bf16x8 a, bf16x8 b, f32x16 c) { return __builtin_amdgcn_mfma_f32_32x32x16_bf16(a, b, c, 0, 0, 0); }
DEVI f32x4 mfma16(bf16x8 a, bf16x8 b, f32x4 c) { return __builtin_amdgcn_mfma_f32_16x16x32_bf16(a, b, c, 0, 0, 0); }
DEVI bf16x8 ld8(const bf16_t* p) { return *(const bf16x8*)p; }
DEVI float shx32(float v) { return __shfl_xor(v, 32, 64); }
DEVI void unpack8(uint4 v, float* f) {
  f[0] = lo2f(v.x); f[1] = hi2f(v.x); f[2] = lo2f(v.y); f[3] = hi2f(v.y);
  f[4] = lo2f(v.z); f[5] = hi2f(v.z); f[6] = lo2f(v.w); f[7] = hi2f(v.w);
}

constexpr int GLD = 72;
template <int NI>
DEVI void gemm_mainloop(const bf16_t* __restrict__ A, int lda, const bf16_t* __restrict__ Bt, int ldb, int K,
                        char* smem, f32x16 (&acc)[NI][2]) {
  bf16_t* sA = (bf16_t*)smem;
  bf16_t* sB = sA + 128 * GLD;
  const int tid = tidx(), lane = tid & 63, w = tid >> 6;
  const int wm = w & 1, wn = w >> 1;
  const int r = lane & 31, hh = lane >> 5;
  u32x4 ra0, ra1, ra2, ra3, rb0, rb1, rb2, rb3;
  const int lrow = tid >> 3, lcol = (tid & 7) * 8;
  const bf16_t* Ap = A + (size_t)lrow * lda + lcol;
  const bf16_t* Bp = Bt + (size_t)lrow * ldb + lcol;
  ra0 = *(const u32x4*)(Ap); ra1 = *(const u32x4*)(Ap + (size_t)32 * lda);
  ra2 = *(const u32x4*)(Ap + (size_t)64 * lda); ra3 = *(const u32x4*)(Ap + (size_t)96 * lda);
  rb0 = *(const u32x4*)(Bp); rb1 = *(const u32x4*)(Bp + (size_t)32 * ldb);
  if (NI == 2) { rb2 = *(const u32x4*)(Bp + (size_t)64 * ldb); rb3 = *(const u32x4*)(Bp + (size_t)96 * ldb); }
  bf16_t* sAw = sA + lrow * GLD + lcol;
  bf16_t* sBw = sB + lrow * GLD + lcol;
  for (int k0 = 0; k0 < K; k0 += 64) {
    __syncthreads();
    *(u32x4*)(sAw) = ra0; *(u32x4*)(sAw + 32 * GLD) = ra1; *(u32x4*)(sAw + 64 * GLD) = ra2; *(u32x4*)(sAw + 96 * GLD) = ra3;
    *(u32x4*)(sBw) = rb0; *(u32x4*)(sBw + 32 * GLD) = rb1;
    if (NI == 2) { *(u32x4*)(sBw + 64 * GLD) = rb2; *(u32x4*)(sBw + 96 * GLD) = rb3; }
    __syncthreads();
    if (k0 + 64 < K) {
      Ap += 64; Bp += 64;
      ra0 = *(const u32x4*)(Ap); ra1 = *(const u32x4*)(Ap + (size_t)32 * lda);
      ra2 = *(const u32x4*)(Ap + (size_t)64 * lda); ra3 = *(const u32x4*)(Ap + (size_t)96 * lda);
      rb0 = *(const u32x4*)(Bp); rb1 = *(const u32x4*)(Bp + (size_t)32 * ldb);
      if (NI == 2) { rb2 = *(const u32x4*)(Bp + (size_t)64 * ldb); rb3 = *(const u32x4*)(Bp + (size_t)96 * ldb); }
    }
#pragma unroll
    for (int ks = 0; ks < 4; ks++) {
      bf16x8 af[2], bfr[NI];
#pragma unroll
      for (int i = 0; i < 2; i++) af[i] = ld8(sA + (wm * 64 + i * 32 + r) * GLD + ks * 16 + hh * 8);
#pragma unroll
      for (int i = 0; i < NI; i++) bfr[i] = ld8(sB + (wn * 32 * NI + i * 32 + r) * GLD + ks * 16 + hh * 8);
#pragma unroll
      for (int ni = 0; ni < NI; ni++)
#pragma unroll
        for (int mi = 0; mi < 2; mi++) acc[ni][mi] = mfma32(bfr[ni], af[mi], acc[ni][mi]);
    }
  }
}
template <int NI, class Epi>
DEVI void gemm_epilogue(f32x16 (&acc)[NI][2], Epi epi) {
  const int tid = tidx(), lane = tid & 63, w = tid >> 6;
  const int wm = w & 1, wn = w >> 1;
  const int r = lane & 31, hh = lane >> 5;
#pragma unroll
  for (int ni = 0; ni < NI; ni++)
#pragma unroll
    for (int mi = 0; mi < 2; mi++)
#pragma unroll
      for (int g = 0; g < 4; g++) {
        f32x4 v = {acc[ni][mi][4 * g], acc[ni][mi][4 * g + 1], acc[ni][mi][4 * g + 2], acc[ni][mi][4 * g + 3]};
        epi(wm * 64 + mi * 32 + r, wn * 32 * NI + ni * 32 + 8 * g + 4 * hh, v);
      }
}
template <int NI>
DEVI void zero_acc(f32x16 (&acc)[NI][2]) {
#pragma unroll
  for (int a = 0; a < NI; a++)
#pragma unroll
    for (int b = 0; b < 2; b++)
#pragma unroll
      for (int i = 0; i < 16; i++) acc[a][b][i] = 0.f;
}

DEVI int inmap(int n) {
  if (n < 2560) return n;
  if (n < 3648) return n + 8;
  if (n < 4160) return n + 16;
  if (n < 4168) return 2560 + (n - 4160);
  if (n < 4176) return 3656 + (n - 4168);
  if (n < 4224) return -1;
  return 4176 + (n - 4224);
}
DEVI void convT_tile(const float* __restrict__ src, int ld_src, const float* __restrict__ ksc, bf16_t* __restrict__ dst,
                     int K, int n0, int k0, bool use_map, char* smem) {
  bf16_t* s = (bf16_t*)smem;
  const int tid = tidx();
#pragma unroll
  for (int i = 0; i < 4; i++) {
    const int e = tid + 256 * i;
    const int kk = e >> 4, n4 = (e & 15) * 4;
    const int col = use_map ? inmap(n0 + n4) : (n0 + n4);
    float4 v = {0.f, 0.f, 0.f, 0.f};
    if (col >= 0) {
      v = *(const float4*)(src + (size_t)(k0 + kk) * ld_src + col);
      if (ksc) { const float g = ksc[k0 + kk]; v.x *= g; v.y *= g; v.z *= g; v.w *= g; }
    }
    s[(n4 + 0) * 72 + kk] = f2bf(v.x);
    s[(n4 + 1) * 72 + kk] = f2bf(v.y);
    s[(n4 + 2) * 72 + kk] = f2bf(v.z);
    s[(n4 + 3) * 72 + kk] = f2bf(v.w);
  }
  __syncthreads();
#pragma unroll
  for (int i = 0; i < 2; i++) {
    int e = tid + 256 * i;
    int nn = e >> 3, c8 = e & 7;
    *(uint4*)(dst + (size_t)(n0 + nn) * K + k0 + c8 * 8) = *(const uint4*)(s + nn * 72 + c8 * 8);
  }
  __syncthreads();
}

DEVI void phase0(const Params& p, char* smem) {
  char* ws = p.ws;
  const int NT_IN = 4 * 114 * 16, NT_GLU = 4 * 64, NT_Q = 4 * 64, NT_BR = 4 * 384, NT_OUT = 4 * 256;
  const int total = NT_IN + NT_GLU + NT_Q + NT_BR + NT_OUT;
  for (int id = blockIdx.x; id < total; id += gridDim.x) {
    int j = id;
    if (j < NT_IN) {
      int l = j / (114 * 16), rr = j % (114 * 16);
      int nt = rr / 16, kt = rr % 16;
      convT_tile(p.in[2] + (size_t)l * 1024 * INW, INW, p.in[1] + l * 1024,
                 (bf16_t*)(ws + OFF_WIN) + (size_t)l * NWIN * 1024, 1024, nt * 64, kt * 64, true, smem);
      continue;
    }
    j -= NT_IN;
    if (j < NT_GLU) {
      int l = j / 64, rr = j % 64;
      convT_tile(p.in[11] + (size_t)l * 512 * 512, 512, nullptr, (bf16_t*)(ws + OFF_WGLU) + (size_t)l * 512 * 512, 512,
                 (rr / 8) * 64, (rr % 8) * 64, false, smem);
      continue;
    }
    j -= NT_GLU;
    if (j < NT_Q) {
      int l = j / 64, rr = j % 64;
      int which = rr / 32, r2 = rr % 32;
      const float* src = (which ? p.in[20] : p.in[19]) + (size_t)l * 256 * 512;
      convT_tile(src, 512, p.in[18] + l * 256, (bf16_t*)(ws + OFF_WQ) + (size_t)l * 1024 * 256 + (size_t)which * 512 * 256,
                 256, (r2 / 4) * 64, (r2 % 4) * 64, false, smem);
      continue;
    }
    j -= NT_Q;
    if (j < NT_BR) {
      int l = j / 384, rr = j % 384;
      int n = rr / 128, r2 = rr % 128;
      convT_tile(p.in[23] + ((size_t)l * 3 + n) * 512 * 1024, 1024, nullptr,
                 (bf16_t*)(ws + OFF_WBR) + ((size_t)l * 3 + n) * 1024 * 512, 512, (r2 / 8) * 64, (r2 % 8) * 64, false, smem);
      continue;
    }
    j -= NT_BR;
    {
      int l = j / 256, rr = j % 256;
      convT_tile(p.in[24] + (size_t)l * 1024 * 1024, 1024, nullptr, (bf16_t*)(ws + OFF_WOUT) + (size_t)l * 1024 * 1024,
                 1024, (rr / 16) * 64, (rr % 16) * 64, false, smem);
    }
  }
  const int lane = tidx() & 63, w = tidx() >> 6;
  bf16_t* xb = (bf16_t*)(ws + OFF_XB);
  float* rowsq = (float*)(ws + OFF_ROWSQ);
  for (int row = blockIdx.x * 4 + w; row < T; row += gridDim.x * 4) {
    const float* xr = p.in[0] + (size_t)row * 1024;
    float ss = 0.f;
#pragma unroll
    for (int i = 0; i < 4; i++) {
      float4 v = *(const float4*)(xr + i * 256 + lane * 4);
      *(float4*)(p.out + (size_t)row * 1024 + i * 256 + lane * 4) = v;
      uint2 pk = {pack2(v.x, v.y), pack2(v.z, v.w)};
      *(uint2*)(xb + (size_t)row * 1024 + i * 256 + lane * 4) = pk;
      ss += v.x * v.x + v.y * v.y + v.z * v.z + v.w * v.w;
    }
#pragma unroll
    for (int o = 32; o > 0; o >>= 1) ss += __shfl_xor(ss, o, 64);
    if (lane < 8) rowsq[(size_t)row * 8 + lane] = (lane == 0) ? ss : 0.f;
  }
}

DEVI void load_rowscale(const Params& p, int m0, float* rsc) {
  const float* rowsq = (const float*)(p.ws + OFF_ROWSQ);
  if (tidx() < 128) {
    const float4 a = *(const float4*)(rowsq + (size_t)(m0 + tidx()) * 8);
    const float4 b = *(const float4*)(rowsq + (size_t)(m0 + tidx()) * 8 + 4);
    float s = ((a.x + a.y) + (a.z + a.w)) + ((b.x + b.y) + (b.z + b.w));
    rsc[tidx()] = rsqrtf(s * (1.f / 1024.f) + EPS);
  }
}

DEVI void phase1(const Params& p, int l, char* smem) {
  char* ws = p.ws;
  const bf16_t* xb = (const bf16_t*)(ws + OFF_XB);
  const bf16_t* W = (const bf16_t*)(ws + OFF_WIN) + (size_t)l * NWIN * 1024;
  bf16_t* projb = (bf16_t*)(ws + OFF_PROJ);
  float* small = (float*)(ws + OFF_SMALL);
  unsigned char* gates = (unsigned char*)(ws + OFF_GATES);
  float* rsc = (float*)(smem + 2 * 128 * GLD * 2);
  for (int id = blockIdx.x; id < 128 * 57; id += gridDim.x) {
    const int mt = id / 57, nt = id % 57;
    const int m0 = mt * 128, n0 = nt * 128;
    __syncthreads();
    load_rowscale(p, m0, rsc);
    f32x16 acc[2][2];
    zero_acc<2>(acc);
    gemm_mainloop<2>(xb + (size_t)m0 * 1024, 1024, W + (size_t)n0 * 1024, 1024, 1024, smem, acc);
    if (nt == 32) {
      gemm_epilogue<2>(acc, [&](int ml, int nl, f32x4 v) {
        const float rs = rsc[ml];
        const int m = m0 + ml, n = n0 + nl;
        if (n < C_SMALL) {
          uint2 pk = {pack2(v[0] * rs, v[1] * rs), pack2(v[2] * rs, v[3] * rs)};
          *(uint2*)(projb + (size_t)m * PJ + n) = pk;
        } else if (n < C_SMALL + 16) {
          float4 o = {v[0] * rs, v[1] * rs, v[2] * rs, v[3] * rs};
          *(float4*)(small + (size_t)m * 16 + (n - C_SMALL)) = o;
        }
      });
    } else if (nt < 32) {
      bf16_t* sT = (bf16_t*)smem;
      __syncthreads();
      gemm_epilogue<2>(acc, [&](int ml, int nl, f32x4 v) {
        const float rs = rsc[ml];
        uint2 pk = {pack2(v[0] * rs, v[1] * rs), pack2(v[2] * rs, v[3] * rs)};
        *(uint2*)(sT + ml * 136 + nl) = pk;
      });
      __syncthreads();
      const int tid = tidx();
#pragma unroll
      for (int j = 0; j < 8; j++) {
        const int c = tid + 256 * j;
        const int row = c >> 4, col = (c & 15) * 8;
        *(uint4*)(projb + (size_t)(m0 + row) * PJ + n0 + col) = *(const uint4*)(sT + row * 136 + col);
      }
    } else {
      unsigned char* sG = (unsigned char*)smem;
      __syncthreads();
      gemm_epilogue<2>(acc, [&](int ml, int nl, f32x4 v) {
        const float rs = rsc[ml];
        const unsigned g0 = (unsigned)(sigmf(v[0] * rs) * 255.f + 0.5f), g1 = (unsigned)(sigmf(v[1] * rs) * 255.f + 0.5f);
        const unsigned g2 = (unsigned)(sigmf(v[2] * rs) * 255.f + 0.5f), g3 = (unsigned)(sigmf(v[3] * rs) * 255.f + 0.5f);
        *(unsigned*)(sG + ml * 144 + nl) = g0 | (g1 << 8) | (g2 << 16) | (g3 << 24);
      });
      __syncthreads();
      const int tid = tidx();
      const int gn0 = n0 - N1;
#pragma unroll
      for (int j = 0; j < 4; j++) {
        const int c = tid + 256 * j;
        const int row = c >> 3, col = (c & 7) * 16;
        *(uint4*)(gates + (size_t)(m0 + row) * 3072 + gn0 + col) = *(const uint4*)(sG + row * 144 + col);
      }
    }
  }
}

DEVI void s5_abar(const Params& p, int l, int g, int n, float& abr, float& abi, float& fr, float& fi) {
  const float dt = expf(p.in[9][l * 32 + g]);
  const float ar = p.in[3][(l * 32 + g) * 64 + n], ai = p.in[4][(l * 32 + g) * 64 + n];
  const float mag = expf(ar * dt), ang = ai * dt;
  float sn, cs;
  {
    float k = rintf(ang * 0.15915494309189535f);
    float rr = fmaf(-k, 6.28125f, ang);
    rr = fmaf(-k, 1.9353071795864769e-3f, rr);
    sn = sinf(rr);
    cs = cosf(rr);
  }
  abr = mag * cs;
  abi = mag * sn;
  const float den = ar * ar + ai * ai;
  fr = ((abr - 1.f) * ar + abi * ai) / den;
  fi = (abi * ar - (abr - 1.f) * ai) / den;
}

template <int MODE>
DEVI void s5_chunk_tasks(const Params& p, int l, char* smem) {
  char* ws = p.ws;
  const bf16_t* projb = (const bf16_t*)(ws + OFF_PROJ);
  float2* st = (float2*)(ws + OFF_S5ST);
  bf16_t* yg = (bf16_t*)(ws + OFF_YG);
  const int tid = tidx(), lane = tid & 63, w = tid >> 6;
  float* sU = (float*)smem + w * 1024;
  bf16_t* sH = (bf16_t*)(smem + 16384) + w * (16 * 136);
  const int ntask = NB * 32 * 128 / 4;
  for (int bt = blockIdx.x; bt < ntask; bt += gridDim.x) {
    const int task = bt * 4 + w;
    const int c = task & 127, g = (task >> 7) & 31, b = task >> 12;
    float abr, abi, fr, fi;
    s5_abar(p, l, g, lane, abr, abi, fr, fi);
    float bbr[16], bbi[16];
    {
      const float* br = p.in[5] + ((size_t)(l * 32 + g) * 64 + lane) * 16;
      const float* bi = p.in[6] + ((size_t)(l * 32 + g) * 64 + lane) * 16;
#pragma unroll
      for (int q = 0; q < 4; q++) {
        float4 x = *(const float4*)(br + 4 * q), y = *(const float4*)(bi + 4 * q);
        bbr[4 * q + 0] = fr * x.x - fi * y.x; bbi[4 * q + 0] = fr * y.x + fi * x.x;
        bbr[4 * q + 1] = fr * x.y - fi * y.y; bbi[4 * q + 1] = fr * y.y + fi * x.y;
        bbr[4 * q + 2] = fr * x.z - fi * y.z; bbi[4 * q + 2] = fr * y.z + fi * x.z;
        bbr[4 * q + 3] = fr * x.w - fi * y.w; bbi[4 * q + 3] = fr * y.w + fi * x.w;
      }
    }
    {
      const bf16_t* up = projb + (size_t)(b * SEQ + c * 64 + lane) * PJ + C_UA + g * 16;
      uint4 u0 = *(const uint4*)up, u1 = *(const uint4*)(up + 8);
      float f[16];
      unpack8(u0, f);
      unpack8(u1, f + 8);
#pragma unroll
      for (int q = 0; q < 4; q++) {
        float4 o = {f[4 * q], f[4 * q + 1], f[4 * q + 2], f[4 * q + 3]};
        *(float4*)(sU + lane * 16 + 4 * q) = o;
      }
    }
    const size_t sidx = ((size_t)(b * 32 + g) * 128 + c) * 64 + lane;
    float hr = 0.f, hi = 0.f;
    bf16x8 cf[4];
    if (MODE == 1) {
      float2 h0 = st[sidx];
      hr = h0.x; hi = h0.y;
      const int i = lane & 15, q4 = lane >> 4;
#pragma unroll
      for (int kq = 0; kq < 4; kq++) {
        const float* cp = (kq < 2 ? p.in[7] : p.in[8]) + ((size_t)(l * 32 + g) * 16 + i) * 64 + (kq & 1) * 32 + q4 * 8;
        float4 x = *(const float4*)cp, y = *(const float4*)(cp + 4);
        const float sg = kq < 2 ? 1.f : -1.f;
        bf16x8 v;
        v[0] = (short)f2bf(sg * x.x); v[1] = (short)f2bf(sg * x.y); v[2] = (short)f2bf(sg * x.z); v[3] = (short)f2bf(sg * x.w);
        v[4] = (short)f2bf(sg * y.x); v[5] = (short)f2bf(sg * y.y); v[6] = (short)f2bf(sg * y.z); v[7] = (short)f2bf(sg * y.w);
        cf[kq] = v;
      }
    }
    __syncthreads();
#pragma unroll 1
    for (int sub = 0; sub < 4; sub++) {
#pragma unroll 2
      for (int tt = 0; tt < 16; tt++) {
        const float* ur = sU + (sub * 16 + tt) * 16;
        float bur = 0.f, bui = 0.f;
#pragma unroll
        for (int q = 0; q < 4; q++) {
          float4 u = *(const float4*)(ur + 4 * q);
          bur = fmaf(u.x, bbr[4 * q], bur); bui = fmaf(u.x, bbi[4 * q], bui);
          bur = fmaf(u.y, bbr[4 * q + 1], bur); bui = fmaf(u.y, bbi[4 * q + 1], bui);
          bur = fmaf(u.z, bbr[4 * q + 2], bur); bui = fmaf(u.z, bbi[4 * q + 2], bui);
          bur = fmaf(u.w, bbr[4 * q + 3], bur); bui = fmaf(u.w, bbi[4 * q + 3], bui);
        }
        const float nr = abr * hr - abi * hi + bur;
        const float ni = abr * hi + abi * hr + bui;
        hr = nr; hi = ni;
        if (MODE == 1) {
          sH[tt * 136 + lane] = f2bf(hr);
          sH[tt * 136 + 64 + lane] = f2bf(hi);
        }
      }
      if (MODE == 1) {
        __syncthreads();
        const int i = lane & 15, q4 = lane >> 4;
        f32x4 acc = {0.f, 0.f, 0.f, 0.f};
#pragma unroll
        for (int kq = 0; kq < 4; kq++) acc = mfma16(cf[kq], ld8(sH + i * 136 + kq * 32 + q4 * 8), acc);
        const int t = sub * 16 + i;
        const float4 uu = *(const float4*)(sU + t * 16 + 4 * q4);
        const float4 dd = *(const float4*)(p.in[10] + l * 512 + g * 16 + 4 * q4);
        const float y0 = geluf(acc[0] + dd.x * uu.x), y1 = geluf(acc[1] + dd.y * uu.y);
        const float y2 = geluf(acc[2] + dd.z * uu.z), y3 = geluf(acc[3] + dd.w * uu.w);
        uint2 pk = {pack2(y0, y1), pack2(y2, y3)};
        *(uint2*)(yg + (size_t)(b * SEQ + c * 64 + t) * 512 + g * 16 + 4 * q4) = pk;
        __syncthreads();
      }
    }
    if (MODE == 0) {
      st[sidx] = make_float2(hr, hi);
    }
    __syncthreads();
  }
}

DEVI void s5_carry(const Params& p, int l, int idx) {
  float2* st = (float2*)(p.ws + OFF_S5ST);
  const int n = idx & 63, g = (idx >> 6) & 31, b = idx >> 11;
  float abr, abi, fr, fi;
  s5_abar(p, l, g, n, abr, abi, fr, fi);
  float pr = abr, pi = abi;
#pragma unroll
  for (int i = 0; i < 6; i++) {
    float nr = pr * pr - pi * pi, ni = 2.f * pr * pi;
    pr = nr; pi = ni;
  }
  float hr = 0.f, hi = 0.f;
  float2* s = st + ((size_t)(b * 32 + g) * 128) * 64 + n;
#pragma unroll 1
  for (int c0 = 0; c0 < 128; c0 += 16) {
    float2 e[16];
#pragma unroll
    for (int j = 0; j < 16; j++) e[j] = s[(size_t)(c0 + j) * 64];
#pragma unroll
    for (int j = 0; j < 16; j++) {
      s[(size_t)(c0 + j) * 64] = make_float2(hr, hi);
      const float nr = pr * hr - pi * hi + e[j].x;
      const float ni = pr * hi + pi * hr + e[j].y;
      hr = nr; hi = ni;
    }
  }
}

template <bool TRANSPOSED>
DEVI void conv_tile(const Params& p, int l, int b, int c, int h, int which, float scale, const float* rowscale, bf16_t* dst) {
  const bf16_t* projb = (const bf16_t*)(p.ws + OFF_PROJ);
  const int tid = tidx();
  const float* cw = p.in[13] + (size_t)l * 4 * 1024;
  const float* cb = p.in[14] + (size_t)l * 1024;
#pragma unroll
  for (int i = 0; i < 4; i++) {
    const int e = tid + 256 * i;
    const int tt = e >> 4, d8 = (e & 15) * 8;
    const int ch = which * 512 + h * 128 + d8;
    const int t = c * 64 + tt;
    float acc[8];
    {
      float4 b0 = *(const float4*)(cb + ch), b1 = *(const float4*)(cb + ch + 4);
      acc[0] = b0.x; acc[1] = b0.y; acc[2] = b0.z; acc[3] = b0.w;
      acc[4] = b1.x; acc[5] = b1.y; acc[6] = b1.z; acc[7] = b1.w;
    }
#pragma unroll
    for (int j = 0; j < 4; j++) {
      const int ts = t - 3 + j;
      if (ts >= 0) {
        uint4 xv = *(const uint4*)(projb + (size_t)(b * SEQ + ts) * PJ + C_QB + ch);
        float xf[8];
        unpack8(xv, xf);
        float4 w0 = *(const float4*)(cw + j * 1024 + ch), w1 = *(const float4*)(cw + j * 1024 + ch + 4);
        acc[0] = fmaf(w0.x, xf[0], acc[0]); acc[1] = fmaf(w0.y, xf[1], acc[1]);
        acc[2] = fmaf(w0.z, xf[2], acc[2]); acc[3] = fmaf(w0.w, xf[3], acc[3]);
        acc[4] = fmaf(w1.x, xf[4], acc[4]); acc[5] = fmaf(w1.y, xf[5], acc[5]);
        acc[6] = fmaf(w1.z, xf[6], acc[6]); acc[7] = fmaf(w1.w, xf[7], acc[7]);
      }
    }
    const float sc = rowscale ? scale * rowscale[tt] : scale;
#pragma unroll
    for (int q = 0; q < 8; q++) acc[q] = siluf(acc[q]) * sc;
    if (!TRANSPOSED) {
      uint4 o = {pack2(acc[0], acc[1]), pack2(acc[2], acc[3]), pack2(acc[4], acc[5]), pack2(acc[6], acc[7])};
      *(uint4*)(dst + tt * 136 + d8) = o;
    } else {
#pragma unroll
      for (int q = 0; q < 8; q++) dst[(d8 + q) * 72 + tt] = f2bf(acc[q]);
    }
  }
}
DEVI void vT_tile(const Params& p, int b, int c, int h, bf16_t* dst) {
  const bf16_t* projb = (const bf16_t*)(p.ws + OFF_PROJ);
  const int tid = tidx();
#pragma unroll
  for (int i = 0; i < 4; i++) {
    const int e = tid + 256 * i;
    const int tt = e >> 4, d8 = (e & 15) * 8;
    uint4 xv = *(const uint4*)(projb + (size_t)(b * SEQ + c * 64 + tt) * PJ + C_VB + h * 128 + d8);
    dst[(d8 + 0) * 72 + tt] = (bf16_t)(xv.x & 0xffffu);
    dst[(d8 + 1) * 72 + tt] = (bf16_t)(xv.x >> 16);
    dst[(d8 + 2) * 72 + tt] = (bf16_t)(xv.y & 0xffffu);
    dst[(d8 + 3) * 72 + tt] = (bf16_t)(xv.y >> 16);
    dst[(d8 + 4) * 72 + tt] = (bf16_t)(xv.z & 0xffffu);
    dst[(d8 + 5) * 72 + tt] = (bf16_t)(xv.z >> 16);
    dst[(d8 + 6) * 72 + tt] = (bf16_t)(xv.w & 0xffffu);
    dst[(d8 + 7) * 72 + tt] = (bf16_t)(xv.w >> 16);
  }
}
DEVI float logsigf(float x) { return fminf(x, 0.f) - log1pf(expf(-fabsf(x))); }

DEVI void mlstm_local(const Params& p, int l, int task, char* smem) {
  char* ws = p.ws;
  const int tid = tidx(), lane = tid & 63, w = tid >> 6;
  const int c = task & 127, h = (task >> 7) & 3, b = task >> 9;
  const int bh = b * 4 + h;
  bf16_t* sKT = (bf16_t*)smem;
  bf16_t* sVT = sKT + 128 * 72;
  float* sW = (float*)(smem + 2 * 128 * 72 * 2);
  const float* small = (const float*)(ws + OFF_SMALL);
  float* msc = (float*)(ws + OFF_MSC);
  __syncthreads();
  if (w == 0) {
    const size_t row = (size_t)(b * SEQ + c * 64 + lane) * 16;
    const float ipre = small[row + h] + p.in[15][l * 4 + h];
    const float lf = logsigf(small[row + 4 + h] + p.in[16][l * 4 + h]);
    float bc = lf;
#pragma unroll
    for (int o = 1; o < 64; o <<= 1) {
      float v = __shfl_up(bc, o, 64);
      if (lane >= o) bc += v;
    }
    const float blast = __shfl(bc, 63, 64);
    const float ge = blast - bc + ipre;
    float mx = ge;
#pragma unroll
    for (int o = 32; o > 0; o >>= 1) mx = fmaxf(mx, __shfl_xor(mx, o, 64));
    sW[lane] = expf(ge - mx);
    if (lane == 0) {
      msc[bh * 128 + c] = mx;
      msc[1024 + bh * 128 + c] = blast;
    }
  }
  __syncthreads();
  conv_tile<true>(p, l, b, c, h, 1, 0.08838834764831845f, sW, sKT);
  vT_tile(p, b, c, h, sVT);
  __syncthreads();
  if (tid < 128) {
    float s = 0.f;
    for (int t = 0; t < 64; t++) s += bf2f(sKT[tid * 72 + t]);
    ((float*)(ws + OFF_MN))[((size_t)bh * 128 + c) * 128 + tid] = s;
  }
  const int r = lane & 31, hh = lane >> 5;
  f32x16 acc[4];
#pragma unroll
  for (int ci = 0; ci < 4; ci++)
#pragma unroll
    for (int i = 0; i < 16; i++) acc[ci][i] = 0.f;
#pragma unroll
  for (int ks = 0; ks < 4; ks++) {
    bf16x8 a = ld8(sVT + (32 * w + r) * 72 + ks * 16 + hh * 8);
#pragma unroll
    for (int ci = 0; ci < 4; ci++) acc[ci] = mfma32(a, ld8(sKT + (32 * ci + r) * 72 + ks * 16 + hh * 8), acc[ci]);
  }
  bf16_t* CT = (bf16_t*)(ws + OFF_MCT) + ((size_t)bh * 128 + c) * 16384;
#pragma unroll
  for (int ci = 0; ci < 4; ci++)
#pragma unroll
    for (int i = 0; i < 16; i++) {
      const int dv = 32 * w + (i & 3) + 8 * (i >> 2) + 4 * hh;
      CT[dv * 128 + 32 * ci + r] = f2bf(acc[ci][i]);
    }
}

DEVI void mlstm_carry(const Params& p, int task, char* smem) {
  char* ws = p.ws;
  const int tid = tidx();
  float* msc = (float*)(ws + OFF_MSC);
  float* sDecay = (float*)smem;
  float* sScale = sDecay + 128;
  const int bh = task / 9, seg = task % 9;
  float* sMl = sScale + 128;
  float* sBl = sMl + 128;
  __syncthreads();
  if (tid < 128) { sMl[tid] = msc[bh * 128 + tid]; sBl[tid] = msc[1024 + bh * 128 + tid]; }
  __syncthreads();
  if (tid == 0) {
    float mprev = 0.f;
    for (int c = 0; c < 128; c++) {
      const float mloc = sMl[c], blast = sBl[c];
      const float mnext = fmaxf(blast + mprev, mloc);
      sDecay[c] = expf(blast + mprev - mnext);
      sScale[c] = expf(mloc - mnext);
      sMl[c] = mprev;
      mprev = mnext;
    }
  }
  __syncthreads();
  if (seg == 0 && tid < 128) msc[2048 + bh * 128 + tid] = sMl[tid];
  if (seg < 8) {
    bf16_t* CT = (bf16_t*)(ws + OFF_MCT) + (size_t)bh * 128 * 16384 + (size_t)(seg * 256 + tid) * 8;
    float cs[8];
#pragma unroll
    for (int q = 0; q < 8; q++) cs[q] = 0.f;
#pragma unroll 1
    for (int c0 = 0; c0 < 128; c0 += 16) {
      u32x4 v[16];
#pragma unroll
      for (int j = 0; j < 16; j++) v[j] = *(const u32x4*)(CT + (size_t)(c0 + j) * 16384);
#pragma unroll
      for (int j = 0; j < 16; j++) {
        u32x4 o = {pack2(cs[0], cs[1]), pack2(cs[2], cs[3]), pack2(cs[4], cs[5]), pack2(cs[6], cs[7])};
        *(u32x4*)(CT + (size_t)(c0 + j) * 16384) = o;
        const float dc = sDecay[c0 + j], sc = sScale[c0 + j];
        cs[0] = dc * cs[0] + sc * lo2f(v[j][0]); cs[1] = dc * cs[1] + sc * hi2f(v[j][0]);
        cs[2] = dc * cs[2] + sc * lo2f(v[j][1]); cs[3] = dc * cs[3] + sc * hi2f(v[j][1]);
        cs[4] = dc * cs[4] + sc * lo2f(v[j][2]); cs[5] = dc * cs[5] + sc * hi2f(v[j][2]);
        cs[6] = dc * cs[6] + sc * lo2f(v[j][3]); cs[7] = dc * cs[7] + sc * hi2f(v[j][3]);
      }
    }
  } else if (tid < 128) {
    float* N = (float*)(ws + OFF_MN) + (size_t)bh * 128 * 128 + tid;
    float ns = 0.f;
#pragma unroll 1
    for (int c0 = 0; c0 < 128; c0 += 16) {
      float v[16];
#pragma unroll
      for (int j = 0; j < 16; j++) v[j] = N[(size_t)(c0 + j) * 128];
#pragma unroll
      for (int j = 0; j < 16; j++) {
        N[(size_t)(c0 + j) * 128] = ns;
        ns = sDecay[c0 + j] * ns + sScale[c0 + j] * v[j];
      }
    }
  }
}

DEVI void mlstm_out(const Params& p, int l, int task, char* smem) {
  char* ws = p.ws;
  const int tid = tidx(), lane = tid & 63, w = tid >> 6;
  const int c = task & 127, h = (task >> 7) & 3, b = task >> 9;
  const int bh = b * 4 + h;
  bf16_t* sQ = (bf16_t*)smem;
  bf16_t* sK = sQ + 64 * 136;
  bf16_t* sVT = sK + 64 * 136;
  float* sA = (float*)(smem + (2 * 64 * 136 + 128 * 72) * 2);
  float* sM = sA + 64;
  float* sBc = sM + 64;
  float* sN = sBc + 64;
  float* sPart = sN + 128;
  const float* small = (const float*)(ws + OFF_SMALL);
  const float* msc = (const float*)(ws + OFF_MSC);
  const float mprev = msc[2048 + bh * 128 + c];
  __syncthreads();
  if (w == 0) {
    const size_t row = (size_t)(b * SEQ + c * 64 + lane) * 16;
    const float ipre = small[row + h] + p.in[15][l * 4 + h];
    const float lf = logsigf(small[row + 4 + h] + p.in[16][l * 4 + h]);
    float bc = lf;
#pragma unroll
    for (int o = 1; o < 64; o <<= 1) {
      float v = __shfl_up(bc, o, 64);
      if (lane >= o) bc += v;
    }
    const float a = ipre - bc;
    float pm = a;
#pragma unroll
    for (int o = 1; o < 64; o <<= 1) {
      float v = __shfl_up(pm, o, 64);
      if (lane >= o) pm = fmaxf(pm, v);
    }
    sA[lane] = a;
    sM[lane] = fmaxf(mprev, pm);
    sBc[lane] = bc;
  }
  if (tid >= 128) sN[tid - 128] = ((const float*)(ws + OFF_MN))[((size_t)bh * 128 + c) * 128 + (tid - 128)];
  conv_tile<false>(p, l, b, c, h, 0, 1.f, nullptr, sQ);
  conv_tile<false>(p, l, b, c, h, 1, 0.08838834764831845f, nullptr, sK);
  vT_tile(p, b, c, h, sVT);
  __syncthreads();
  const int r = lane & 31, hh = lane >> 5;
  const int tt = w & 1, eh = w >> 1;
  const int tl = 32 * tt + r;
  const float Mt = sM[tl], bct = sBc[tl];
  const float mt = bct + Mt;
  const float interw = expf(mprev - Mt);
  float qn = 0.f;
  for (int d = 0; d < 64; d++) qn = fmaf(bf2f(sQ[tl * 136 + hh * 64 + d]), sN[hh * 64 + d], qn);
  qn += shx32(qn);
  f32x16 oacc[2];
#pragma unroll
  for (int ei = 0; ei < 2; ei++)
#pragma unroll
    for (int i = 0; i < 16; i++) oacc[ei][i] = 0.f;
  float den = 0.f;
  for (int si = 0; si <= tt; si++) {
    f32x16 sacc;
#pragma unroll
    for (int i = 0; i < 16; i++) sacc[i] = 0.f;
#pragma unroll
    for (int ks = 0; ks < 8; ks++)
      sacc = mfma32(ld8(sK + (32 * si + r) * 136 + ks * 16 + hh * 8), ld8(sQ + tl * 136 + ks * 16 + hh * 8), sacc);
    float pv[16];
#pragma unroll
    for (int i = 0; i < 16; i++) {
      const int s = 32 * si + (i & 3) + 8 * (i >> 2) + 4 * hh;
      const float v = (s <= tl) ? sacc[i] * expf(sA[s] - Mt) : 0.f;
      pv[i] = v;
      den += v;
    }
#pragma unroll
    for (int k2 = 0; k2 < 2; k2++) {
      bf16x8 pf;
#pragma unroll
      for (int j = 0; j < 8; j++) pf[j] = (short)f2bf(pv[8 * k2 + j]);
#pragma unroll
      for (int ei = 0; ei < 2; ei++) {
        const bf16_t* vp = sVT + (eh * 64 + ei * 32 + r) * 72 + 32 * si + 16 * k2 + 4 * hh;
        uint2 lo = *(const uint2*)vp, hi = *(const uint2*)(vp + 8);
        uint4 av = {lo.x, lo.y, hi.x, hi.y};
        oacc[ei] = mfma32(*(bf16x8*)&av, pf, oacc[ei]);
      }
    }
  }
  den += shx32(den);
  den += interw * qn;
  const bf16_t* CT = (const bf16_t*)(ws + OFF_MCT) + ((size_t)bh * 128 + c) * 16384;
  f32x16 cacc[2];
#pragma unroll
  for (int ei = 0; ei < 2; ei++)
#pragma unroll
    for (int i = 0; i < 16; i++) cacc[ei][i] = 0.f;
#pragma unroll
  for (int ks = 0; ks < 8; ks++) {
    bf16x8 qf = ld8(sQ + tl * 136 + ks * 16 + hh * 8);
#pragma unroll
    for (int ei = 0; ei < 2; ei++)
      cacc[ei] = mfma32(ld8(CT + (size_t)(eh * 64 + ei * 32 + r) * 128 + ks * 16 + hh * 8), qf, cacc[ei]);
  }
  const float dinv = 1.f / fmaxf(fabsf(den), expf(-mt));
  float ssq = 0.f;
#pragma unroll
  for (int ei = 0; ei < 2; ei++)
#pragma unroll
    for (int i = 0; i < 16; i++) {
      const float hv = (oacc[ei][i] + interw * cacc[ei][i]) * dinv;
      oacc[ei][i] = hv;
      ssq += hv * hv;
    }
  ssq += shx32(ssq);
  if (hh == 0) sPart[eh * 64 + tl] = ssq;
  __syncthreads();
  const float rs = rsqrtf((sPart[tl] + sPart[64 + tl]) * (1.f / 128.f) + EPS);
  const bf16_t* projb = (const bf16_t*)(ws + OFF_PROJ);
  bf16_t* ys = (bf16_t*)(ws + OFF_YS) + (size_t)1 * T * 512;
  const size_t tok = (size_t)(b * SEQ + c * 64 + tl);
#pragma unroll
  for (int ei = 0; ei < 2; ei++)
#pragma unroll
    for (int g = 0; g < 4; g++) {
      const int e = eh * 64 + ei * 32 + 8 * g + 4 * hh;
      const float4 gg = *(const float4*)(p.in[17] + l * 512 + h * 128 + e);
      const uint2 zz = *(const uint2*)(projb + tok * PJ + C_ZB + h * 128 + e);
      const float o0 = oacc[ei][4 * g] * rs * gg.x * siluf(lo2f(zz.x));
      const float o1 = oacc[ei][4 * g + 1] * rs * gg.y * siluf(hi2f(zz.x));
      const float o2 = oacc[ei][4 * g + 2] * rs * gg.z * siluf(lo2f(zz.y));
      const float o3 = oacc[ei][4 * g + 3] * rs * gg.w * siluf(hi2f(zz.y));
      uint2 pk = {pack2(o0, o1), pack2(o2, o3)};
      *(uint2*)(ys + tok * 512 + h * 128 + e) = pk;
    }
}

DEVI void qq_tile(const Params& p, int l, int id, char* smem) {
  char* ws = p.ws;
  const bf16_t* projb = (const bf16_t*)(ws + OFF_PROJ);
  const bf16_t* W = (const bf16_t*)(ws + OFF_WQ) + (size_t)l * 1024 * 256;
  bf16_t* qq = (bf16_t*)(ws + OFF_QQ);
  float* rsc = (float*)(smem + 2 * 128 * GLD * 2);
  const int mt = id >> 3, nt = id & 7;
  const int m0 = mt * 128, n0 = nt * 128;
  const int tid = tidx();
  __syncthreads();
  {
    const int row = tid >> 1, half = tid & 1;
    const bf16_t* cp = projb + (size_t)(m0 + row) * PJ + C_CQ + half * 128;
    float ss = 0.f;
#pragma unroll
    for (int i = 0; i < 16; i++) {
      uint4 v = *(const uint4*)(cp + i * 8);
      float f[8];
      unpack8(v, f);
#pragma unroll
      for (int q = 0; q < 8; q++) ss = fmaf(f[q], f[q], ss);
    }
    ss += __shfl_xor(ss, 1, 64);
    if (half == 0) rsc[row] = rsqrtf(ss * (1.f / 256.f) + EPS);
  }
  f32x16 acc[2][2];
  zero_acc<2>(acc);
  gemm_mainloop<2>(projb + (size_t)m0 * PJ + C_CQ, PJ, W + (size_t)n0 * 256, 256, 256, smem, acc);
  {
    bf16_t* sT = (bf16_t*)smem;
    __syncthreads();
    gemm_epilogue<2>(acc, [&](int ml, int nl, f32x4 v) {
      const float rs = rsc[ml];
      uint2 pk = {pack2(v[0] * rs, v[1] * rs), pack2(v[2] * rs, v[3] * rs)};
      *(uint2*)(sT + ml * 136 + nl) = pk;
    });
    __syncthreads();
#pragma unroll
    for (int j = 0; j < 8; j++) {
      const int c = tid + 256 * j;
      const int row = c >> 4, col = (c & 15) * 8;
      *(uint4*)(qq + (size_t)(m0 + row) * 1024 + n0 + col) = *(const uint4*)(sT + row * 136 + col);
    }
  }
}
DEVI void kiv_task(const Params& p, int l, int id, char* smem) {
  char* ws = p.ws;
  const bf16_t* projb = (const bf16_t*)(ws + OFF_PROJ);
  bf16_t* ki = (bf16_t*)(ws + OFF_KI);
  bf16_t* vT = (bf16_t*)(ws + OFF_VT);
  bf16_t* sT = (bf16_t*)smem;
  const int tid = tidx();
  const int tok0 = id * 64;
  const int b = tok0 / SEQ, s0 = tok0 % SEQ;
  __syncthreads();
  {
    const int tk = tid >> 2, qd = tid & 3;
    const bf16_t* kp = projb + (size_t)(tok0 + tk) * PJ + C_KIDX + qd * 16;
    float f[16];
    unpack8(*(const uint4*)kp, f);
    unpack8(*(const uint4*)(kp + 8), f + 8);
    float mu = 0.f;
#pragma unroll
    for (int i = 0; i < 16; i++) mu += f[i];
    mu += __shfl_xor(mu, 1, 64);
    mu += __shfl_xor(mu, 2, 64);
    mu *= (1.f / 64.f);
    float var = 0.f;
#pragma unroll
    for (int i = 0; i < 16; i++) { f[i] -= mu; var = fmaf(f[i], f[i], var); }
    var += __shfl_xor(var, 1, 64);
    var += __shfl_xor(var, 2, 64);
    const float rs = rsqrtf(var * (1.f / 64.f) + EPS);
    const float* g = p.in[21] + l * 64 + qd * 16;
    const float* bb = p.in[22] + l * 64 + qd * 16;
    float o[16];
#pragma unroll
    for (int i = 0; i < 16; i++) o[i] = f[i] * rs * g[i] + bb[i];
    uint4 o0 = {pack2(o[0], o[1]), pack2(o[2], o[3]), pack2(o[4], o[5]), pack2(o[6], o[7])};
    uint4 o1 = {pack2(o[8], o[9]), pack2(o[10], o[11]), pack2(o[12], o[13]), pack2(o[14], o[15])};
    *(uint4*)(ki + (size_t)(tok0 + tk) * 64 + qd * 16) = o0;
    *(uint4*)(ki + (size_t)(tok0 + tk) * 64 + qd * 16 + 8) = o1;
  }
  {
    const int tk = tid >> 2, part = tid & 3;
    const bf16_t* kp = projb + (size_t)(tok0 + tk) * PJ + C_KC + part * 32;
    float ss = 0.f;
#pragma unroll
    for (int k = 0; k < 4; k++) {
      float f[8];
      unpack8(*(const uint4*)(kp + 8 * k), f);
#pragma unroll
      for (int q = 0; q < 8; q++) ss = fmaf(f[q], f[q], ss);
    }
#pragma unroll
    for (int o = 1; o < 64; o <<= 1) ss = (o < 4) ? ss + __shfl_xor(ss, o, 64) : fmaxf(ss, __shfl_xor(ss, o, 64));
    if ((tid & 63) == 0) {
      unsigned* km = (unsigned*)(ws + OFF_KMAX) + l * 2 + b;
      const unsigned bits = __float_as_uint(ss);
      if (bits > __hip_atomic_load(km, __ATOMIC_RELAXED, __HIP_MEMORY_SCOPE_AGENT)) atomicMax(km, bits);
    }
  }
#pragma unroll
  for (int i = 0; i < 4; i++) {
    const int e = tid + 256 * i;
    const int tt = e >> 4, d8 = (e & 15) * 8;
    uint4 xv = *(const uint4*)(projb + (size_t)(tok0 + tt) * PJ + C_VC + d8);
    sT[(d8 + 0) * 72 + tt] = (bf16_t)(xv.x & 0xffffu);
    sT[(d8 + 1) * 72 + tt] = (bf16_t)(xv.x >> 16);
    sT[(d8 + 2) * 72 + tt] = (bf16_t)(xv.y & 0xffffu);
    sT[(d8 + 3) * 72 + tt] = (bf16_t)(xv.y >> 16);
    sT[(d8 + 4) * 72 + tt] = (bf16_t)(xv.z & 0xffffu);
    sT[(d8 + 5) * 72 + tt] = (bf16_t)(xv.z >> 16);
    sT[(d8 + 6) * 72 + tt] = (bf16_t)(xv.w & 0xffffu);
    sT[(d8 + 7) * 72 + tt] = (bf16_t)(xv.w >> 16);
  }
  __syncthreads();
#pragma unroll
  for (int i = 0; i < 4; i++) {
    const int e = tid + 256 * i;
    const int d = e >> 3, c8 = (e & 7) * 8;
    *(uint4*)(vT + ((size_t)b * 128 + d) * SEQ + s0 + c8) = *(const uint4*)(sT + d * 72 + c8);
  }
}

constexpr int QLD = 584;
DEVI void load_kf(bf16x8 (&kf)[4], const bf16_t* __restrict__ kib, int s0, int i, int q4) {
#pragma unroll
  for (int kt = 0; kt < 2; kt++)
#pragma unroll
    for (int kq = 0; kq < 2; kq++) kf[kt * 2 + kq] = ld8(kib + (size_t)(s0 + 16 * kt + i) * 64 + 32 * kq + 8 * q4);
}
DEVI void score_tile(const bf16x8 (&kf)[4], const bf16x8 (&qr)[18], const float (&wh)[8], f32x4& sc0, f32x4& sc1) {
  sc0 = {0.f, 0.f, 0.f, 0.f};
  sc1 = {0.f, 0.f, 0.f, 0.f};
  sc0 = mfma16(kf[0], qr[16], sc0);
  sc0 = mfma16(kf[1], qr[17], sc0);
  sc1 = mfma16(kf[2], qr[16], sc1);
  sc1 = mfma16(kf[3], qr[17], sc1);
#pragma unroll
  for (int h = 0; h < 8; h++) {
    f32x4 d0 = {0.f, 0.f, 0.f, 0.f}, d1 = {0.f, 0.f, 0.f, 0.f};
    d0 = mfma16(kf[0], qr[2 * h], d0);
    d0 = mfma16(kf[1], qr[2 * h + 1], d0);
    d1 = mfma16(kf[2], qr[2 * h], d1);
    d1 = mfma16(kf[3], qr[2 * h + 1], d1);
#pragma unroll
    for (int rg = 0; rg < 4; rg++) {
      sc0[rg] = fmaf(fabsf(d0[rg]), wh[h], sc0[rg]);
      sc1[rg] = fmaf(fabsf(d1[rg]), wh[h], sc1[rg]);
    }
  }
}
DEVI unsigned monokey(float f) {
  unsigned u = __float_as_uint(f);
  return (u & 0x80000000u) ? ~u : (u | 0x80000000u);
}

constexpr int DSA_OFF_STAGE = 16 * QLD * 2;
constexpr int KLD = 136, VLD = 72;
constexpr int DSA_STAGE_BYTES = 64 * KLD * 2 + 128 * VLD * 2;
constexpr int DSA_OFF_HIST = DSA_OFF_STAGE;
constexpr int DSA_OFF_CODE = DSA_OFF_HIST + 16 * 129 * 4;
constexpr int DSA_OFF_SEGS = DSA_OFF_CODE + 16 * 129 * 4;
constexpr int DSA_OFF_MASKA = DSA_OFF_STAGE + 18048;
static_assert(DSA_OFF_SEGS + 176 * 4 <= DSA_OFF_MASKA, "layout");
static_assert(DSA_OFF_MASKA + 16384 <= DSA_OFF_STAGE + DSA_STAGE_BYTES, "layout");
constexpr int DSA_OFF_WQ = DSA_OFF_STAGE + DSA_STAGE_BYTES;
constexpr int DSA_OFF_MISC = DSA_OFF_WQ + 512;
static_assert(DSA_OFF_MISC + 256 <= SMEM_BYTES, "LDS overflow");
constexpr int QB = 16;

DEVI void dsa_task(const Params& p, int l, int b, int t0, char* smem) {
  char* ws = p.ws;
  bf16_t* sQI = (bf16_t*)smem;
  unsigned char* maskF = (unsigned char*)smem;
  unsigned* hist = (unsigned*)(smem + DSA_OFF_HIST);
  unsigned* code = (unsigned*)(smem + DSA_OFF_CODE);
  unsigned* segs = (unsigned*)(smem + DSA_OFF_SEGS);
  unsigned* pref = segs + 128;
  int* krem = (int*)(pref + 16);
  unsigned* thr = (unsigned*)(krem + 16);
  unsigned char* maskA = (unsigned char*)(smem + DSA_OFF_MASKA);
  unsigned* maskAw = (unsigned*)(smem + DSA_OFF_MASKA);
  bf16_t* sK = (bf16_t*)(smem + DSA_OFF_STAGE);
  bf16_t* sVT = sK + 64 * KLD;
  float* sWq = (float*)(smem + DSA_OFF_WQ);
  int* cnt = (int*)(smem + DSA_OFF_MISC);
  int* ovf = cnt + 32;
  const int tid = tidx(), lane = tid & 63, w = tid >> 6;
  const int i = lane & 15, q4 = lane >> 4;
  const bf16_t* qq = (const bf16_t*)(ws + OFF_QQ);
  const bf16_t* projb = (const bf16_t*)(ws + OFF_PROJ);
  const bf16_t* kib = (const bf16_t*)(ws + OFF_KI) + (size_t)b * SEQ * 64;
  const bf16_t* vT = (const bf16_t*)(ws + OFF_VT) + (size_t)b * 128 * SEQ;
  const float* small = (const float*)(ws + OFF_SMALL);
  const int n_it = (t0 + QB + 127) >> 7;
  const int tq = t0 + i;
  const int tlast = t0 + QB - 1;
  const bool need_sel = (tlast > 255);
  __syncthreads();
  if (tid < 16) { thr[tid] = 0u; pref[tid] = 0u; krem[tid] = 256; cnt[tid] = 0; }
  if (tid == 0) *ovf = 0;
  for (int k = tid; k < 16 * 129; k += 256) hist[k] = 0u;
  {
    uint4 z = {0u, 0u, 0u, 0u};
#pragma unroll
    for (int k = 0; k < 4; k++) *(uint4*)(maskA + (tid * 4 + k) * 16) = z;
  }
  __syncthreads();
  if (need_sel) {
    bf16x8 qr[18];
    float wh[8];
    {
      const bf16_t* qrow = qq + (size_t)(b * SEQ + t0 + i) * 1024 + 512 + 8 * q4;
#pragma unroll
      for (int h = 0; h < 8; h++) { qr[2 * h] = ld8(qrow + h * 64); qr[2 * h + 1] = ld8(qrow + h * 64 + 32); }
      const float4 w0 = *(const float4*)(small + (size_t)(b * SEQ + t0 + i) * 16 + 8);
      const float4 w1 = *(const float4*)(small + (size_t)(b * SEQ + t0 + i) * 16 + 12);
      const float sc = 0.5f * 0.044194173824159216f;
      wh[0] = w0.x * sc; wh[1] = w0.y * sc; wh[2] = w0.z * sc; wh[3] = w0.w * sc;
      wh[4] = w1.x * sc; wh[5] = w1.y * sc; wh[6] = w1.z * sc; wh[7] = w1.w * sc;
#pragma unroll
      for (int kq = 0; kq < 2; kq++) {
        float a[8];
#pragma unroll
        for (int j = 0; j < 8; j++) a[j] = 0.f;
#pragma unroll
        for (int h = 0; h < 8; h++) {
#pragma unroll
          for (int j = 0; j < 8; j++) a[j] = fmaf(wh[h], bf2f((bf16_t)qr[2 * h + kq][j]), a[j]);
        }
        bf16x8 o;
#pragma unroll
        for (int j = 0; j < 8; j++) o[j] = (short)f2bf(a[j]);
        qr[16 + kq] = o;
      }
    }
#pragma unroll 1
    for (int pass = 0; pass < 5; pass++) {
      const int shift = 24 - 8 * pass;
      const unsigned pf = pref[i];
      const bool collect = (pass == 2) && (*ovf == 0);
      const bool maskthr = (pass == 4);
      const unsigned thr_i = thr[i];
      bf16x8 kf[4], kn[4], kn2[4];
      load_kf(kf, kib, w * 32, i, q4);
      if (w * 32 + 128 <= tlast) load_kf(kn, kib, w * 32 + 128, i, q4);
#pragma unroll 1
      for (int it = 0; it < n_it; it++) {
        const int s0 = it * 128 + w * 32;
        const bool valid = (s0 <= tlast);
        if (s0 + 256 <= tlast) load_kf(kn2, kib, s0 + 256, i, q4);
        if (valid) {
          f32x4 sc0, sc1;
          score_tile(kf, qr, wh, sc0, sc1);
          unsigned bits = 0u;
#pragma unroll
          for (int e = 0; e < 8; e++) {
            const int s = s0 + 16 * (e >> 2) + 4 * q4 + (e & 3);
            const unsigned key = monokey((e < 4) ? sc0[e & 3] : sc1[e & 3]);
            if (s <= tq) {
              if (collect) {
                const unsigned k16 = key >> 16;
                if (k16 > pf) bits |= (1u << e);
                else if (k16 == pf) {
                  const int idx = atomicAdd(&cnt[i], 1);
                  if (idx < 128) { hist[i * 129 + idx] = key; code[i * 129 + idx] = ((unsigned)((it * 4 + w) * 64 + lane) << 3) | (unsigned)e; }
                }
              } else if (maskthr) {
                if (key >= thr_i) bits |= (1u << e);
              } else if (pass == 0 || ((key >> (shift + 8)) == pf)) {
                const unsigned bin = (key >> shift) & 255u;
                atomicAdd(&hist[i * 129 + (bin >> 1)], 1u << ((bin & 1u) * 16));
              }
            }
          }
          if (collect || maskthr) maskA[(it * 4 + w) * 64 + lane] = (unsigned char)bits;
        }
#pragma unroll
        for (int ks = 0; ks < 4; ks++) { kf[ks] = kn[ks]; kn[ks] = kn2[ks]; }
      }
      __syncthreads();
      if (maskthr) break;
      if (collect) {
        if (tid < 128) {
          const int q = tid >> 3, j = tid & 7;
          const int nraw = cnt[q];
          const int n = nraw < 128 ? nraw : 128;
          const int kr = krem[q];
          if (nraw > 128) *ovf = 1;
          for (int e = j; e < n; e += 8) {
            const unsigned ke = hist[q * 129 + e];
            int g = 0, ge = 0;
            for (int f = 0; f < n; f++) {
              const unsigned kf2 = hist[q * 129 + f];
              g += (kf2 > ke) ? 1 : 0;
              ge += (kf2 >= ke) ? 1 : 0;
            }
            if (g < kr && ge >= kr) thr[q] = ke;
          }
        }
        __syncthreads();
        if (*ovf == 0) {
          if (tid < 128) {
            const int q = tid >> 3, j = tid & 7;
            const int n = cnt[q];
            const unsigned tq2 = thr[q];
            for (int e = j; e < n; e += 8) {
              if (hist[q * 129 + e] >= tq2) {
                const unsigned cd = code[q * 129 + e];
                const unsigned byte = cd >> 3, bit = cd & 7u;
                atomicOr(&maskAw[byte >> 2], 1u << ((byte & 3u) * 8 + bit));
              }
            }
          }
          __syncthreads();
          break;
        }
        for (int k = tid; k < 16 * 129; k += 256) hist[k] = 0u;
        __syncthreads();
        pass--;
        continue;
      }
      if (tid < 128) {
        const int q = tid >> 3, j = tid & 7;
        unsigned ssum = 0;
#pragma unroll
        for (int k = 0; k < 16; k++) {
          const unsigned wv = hist[q * 129 + 16 * j + k];
          ssum += (wv & 0xffffu) + (wv >> 16);
        }
        segs[q * 8 + j] = ssum;
      }
      __syncthreads();
      if (tid < 16) {
        const int q = tid;
        const int kr = krem[q];
        int cum = 0, j = 7;
        while (j > 0 && cum + (int)segs[q * 8 + j] < kr) { cum += (int)segs[q * 8 + j]; j--; }
        int bin = 32 * j + 31;
        while (bin > 32 * j) {
          const unsigned wv = hist[q * 129 + (bin >> 1)];
          const int c2 = (bin & 1) ? (int)(wv >> 16) : (int)(wv & 0xffffu);
          if (cum + c2 >= kr) break;
          cum += c2;
          bin--;
        }
        pref[q] = (pref[q] << 8) | (unsigned)bin;
        krem[q] = kr - cum;
        if (pass == 3) thr[q] = pref[q];
      }
      __syncthreads();
      for (int k = tid; k < 16 * 129; k += 256) hist[k] = 0u;
      __syncthreads();
    }
  } else {
    for (int it = 0; it < n_it; it++) {
      const int s0 = it * 128 + w * 32;
      unsigned bits = 0u;
#pragma unroll
      for (int e = 0; e < 8; e++) {
        const int s = s0 + 16 * (e >> 2) + 4 * q4 + (e & 3);
        if (s <= tq) bits |= (1u << e);
      }
      maskA[(it * 4 + w) * 64 + lane] = (unsigned char)bits;
    }
    __syncthreads();
  }
  {
    uint4 mv[4];
#pragma unroll
    for (int k = 0; k < 4; k++) mv[k] = *(const uint4*)(maskA + (tid * 4 + k) * 16);
#pragma unroll
    for (int k = 0; k < 4; k++) *(uint4*)(maskF + (tid * 4 + k) * 16) = mv[k];
  }
  __syncthreads();
  const int hp = w >> 1, hf = w & 1;
  bf16x8 qf[2][4];
#pragma unroll
  for (int hd = 0; hd < 2; hd++)
#pragma unroll
    for (int kq = 0; kq < 4; kq++)
      qf[hd][kq] = ld8(qq + (size_t)(b * SEQ + t0 + i) * 1024 + (2 * hp + hd) * 128 + 32 * kq + 8 * q4);
  f32x4 O[2][8];
#pragma unroll
  for (int hd = 0; hd < 2; hd++)
#pragma unroll
    for (int dt = 0; dt < 8; dt++) O[hd][dt] = {0.f, 0.f, 0.f, 0.f};
  float l_run[2] = {0.f, 0.f};
  const float scale = 0.08838834764831845f;
  float m_ref[2];
  {
    const float kmax2 = __uint_as_float(__hip_atomic_load((const unsigned*)(ws + OFF_KMAX) + l * 2 + b, __ATOMIC_RELAXED, __HIP_MEMORY_SCOPE_AGENT));
#pragma unroll
    for (int hd = 0; hd < 2; hd++) {
      float qn = 0.f;
#pragma unroll
      for (int kq = 0; kq < 4; kq++)
#pragma unroll
        for (int j = 0; j < 8; j++) { const float v = bf2f((bf16_t)qf[hd][kq][j]); qn = fmaf(v, v, qn); }
      qn += __shfl_xor(qn, 16, 64);
      qn += __shfl_xor(qn, 32, 64);
      m_ref[hd] = fminf(sqrtf(qn * kmax2) * scale, 40.f);
    }
  }
  const int krow = tid >> 2, kcol = (tid & 3) * 32;
  const int vrow = tid >> 1, vcol = (tid & 1) * 32;
  const bf16_t* kg = projb + (size_t)(b * SEQ + krow) * PJ + C_KC + kcol;
  const bf16_t* vg = vT + (size_t)vrow * SEQ + vcol;
  u32x4 pk[4], pvr[4];
#pragma unroll
  for (int k = 0; k < 4; k++) { pk[k] = *(const u32x4*)(kg + 8 * k); pvr[k] = *(const u32x4*)(vg + 8 * k); }
#pragma unroll 1
  for (int ss0 = 0; ss0 <= tlast; ss0 += 64) {
    __syncthreads();
#pragma unroll
    for (int k = 0; k < 4; k++) {
      *(u32x4*)(sK + krow * KLD + kcol + 8 * k) = pk[k];
      *(u32x4*)(sVT + vrow * VLD + vcol + 8 * k) = pvr[k];
    }
    __syncthreads();
    if (ss0 + 64 <= tlast) {
      const bf16_t* kg2 = kg + (size_t)(ss0 + 64) * PJ;
      const bf16_t* vg2 = vg + ss0 + 64;
#pragma unroll
      for (int k = 0; k < 4; k++) { pk[k] = *(const u32x4*)(kg2 + 8 * k); pvr[k] = *(const u32x4*)(vg2 + 8 * k); }
    }
    const unsigned mb = (unsigned)maskF[((ss0 >> 5) + hf) * 64 + lane];
    if (__ballot(mb != 0u) == 0ull) continue;
    f32x4 sa[2][2];
#pragma unroll
    for (int hd = 0; hd < 2; hd++)
#pragma unroll
      for (int kt = 0; kt < 2; kt++) sa[hd][kt] = {0.f, 0.f, 0.f, 0.f};
#pragma unroll
    for (int kq = 0; kq < 4; kq++)
#pragma unroll
      for (int kt = 0; kt < 2; kt++) {
        const bf16x8 kfr = ld8(sK + (32 * hf + 16 * kt + i) * KLD + 32 * kq + 8 * q4);
        sa[0][kt] = mfma16(kfr, qf[0][kq], sa[0][kt]);
        sa[1][kt] = mfma16(kfr, qf[1][kq], sa[1][kt]);
      }
    bf16x8 pf[2];
#pragma unroll
    for (int hd = 0; hd < 2; hd++) {
      float lsum = 0.f;
#pragma unroll
      for (int e = 0; e < 8; e++) {
        const float pe = ((mb >> e) & 1u) ? __expf(fmaf(sa[hd][e >> 2][e & 3], scale, -m_ref[hd])) : 0.f;
        pf[hd][e] = (short)f2bf(pe);
        lsum += pe;
      }
      l_run[hd] += lsum;
    }
#pragma unroll
    for (int dt = 0; dt < 8; dt++) {
      const bf16_t* vp = sVT + (16 * dt + i) * VLD + 32 * hf + 4 * q4;
      uint2 lo = *(const uint2*)vp, hi = *(const uint2*)(vp + 16);
      uint4 av = {lo.x, lo.y, hi.x, hi.y};
      O[0][dt] = mfma16(*(bf16x8*)&av, pf[0], O[0][dt]);
      O[1][dt] = mfma16(*(bf16x8*)&av, pf[1], O[1][dt]);
    }
  }
  __syncthreads();
#pragma unroll
  for (int hd = 0; hd < 2; hd++) {
    l_run[hd] += __shfl_xor(l_run[hd], 16, 64);
    l_run[hd] += __shfl_xor(l_run[hd], 32, 64);
  }
  float* mO = (float*)(smem + DSA_OFF_STAGE);
  float* mML = mO + 2 * 2 * 8 * 64 * 4;
  if (hf == 1) {
#pragma unroll
    for (int hd = 0; hd < 2; hd++) {
#pragma unroll
      for (int dt = 0; dt < 8; dt++) *(f32x4*)(mO + ((((hp * 2 + hd) * 8 + dt) * 64 + lane) << 2)) = O[hd][dt];
      mML[(hp * 2 + hd) * 64 + lane] = l_run[hd];
    }
  }
  __syncthreads();
  if (hf == 0) {
    bf16_t* ys = (bf16_t*)(ws + OFF_YS) + (size_t)2 * T * 512;
    const size_t tok = (size_t)(b * SEQ + t0 + i);
#pragma unroll
    for (int hd = 0; hd < 2; hd++) {
      const float linv = 1.f / (l_run[hd] + mML[(hp * 2 + hd) * 64 + lane]);
      const int head = 2 * hp + hd;
#pragma unroll
      for (int dt = 0; dt < 8; dt++) {
        const f32x4 o1 = *(const f32x4*)(mO + ((((hp * 2 + hd) * 8 + dt) * 64 + lane) << 2));
        const int d = 16 * dt + 4 * q4;
        const uint2 zz = *(const uint2*)(projb + tok * PJ + C_ZC + head * 128 + d);
        const float o0 = (O[hd][dt][0] + o1[0]) * linv * siluf(lo2f(zz.x));
        const float o1v = (O[hd][dt][1] + o1[1]) * linv * siluf(hi2f(zz.x));
        const float o2 = (O[hd][dt][2] + o1[2]) * linv * siluf(lo2f(zz.y));
        const float o3 = (O[hd][dt][3] + o1[3]) * linv * siluf(hi2f(zz.y));
        uint2 pk2 = {pack2(o0, o1v), pack2(o2, o3)};
        *(uint2*)(ys + tok * 512 + head * 128 + d) = pk2;
      }
    }
  }
}

DEVI void phaseE(const Params& p, int l, char* smem) {
  char* ws = p.ws;
  const bf16_t* yg = (const bf16_t*)(ws + OFF_YG);
  const bf16_t* W = (const bf16_t*)(ws + OFF_WGLU) + (size_t)l * 512 * 512;
  const bf16_t* projb = (const bf16_t*)(ws + OFF_PROJ);
  bf16_t* ys = (bf16_t*)(ws + OFF_YS);
  for (int id = blockIdx.x; id < 128 * 4; id += gridDim.x) {
    const int m0 = (id >> 2) * 128, n0 = (id & 3) * 128;
    f32x16 acc[2][2];
    zero_acc<2>(acc);
    gemm_mainloop<2>(yg + (size_t)m0 * 512, 512, W + (size_t)n0 * 512, 512, 512, smem, acc);
    gemm_epilogue<2>(acc, [&](int ml, int nl, f32x4 v) {
      const size_t m = m0 + ml;
      const int n = n0 + nl;
      const float4 gb = *(const float4*)(p.in[12] + l * 512 + n);
      const uint2 gg = *(const uint2*)(yg + m * 512 + n);
      const uint2 zz = *(const uint2*)(projb + m * PJ + C_ZA + n);
      const float o0 = lo2f(gg.x) * sigmf(v[0] + gb.x) * siluf(lo2f(zz.x));
      const float o1 = hi2f(gg.x) * sigmf(v[1] + gb.y) * siluf(hi2f(zz.x));
      const float o2 = lo2f(gg.y) * sigmf(v[2] + gb.z) * siluf(lo2f(zz.y));
      const float o3 = hi2f(gg.y) * sigmf(v[3] + gb.w) * siluf(hi2f(zz.y));
      uint2 pk = {pack2(o0, o1), pack2(o2, o3)};
      *(uint2*)(ys + m * 512 + n) = pk;
    });
  }
}

DEVI void phaseF(const Params& p, int l, char* smem) {
  char* ws = p.ws;
  const bf16_t* Wb = (const bf16_t*)(ws + OFF_WBR) + (size_t)l * 3 * 1024 * 512;
  const bf16_t* ys = (const bf16_t*)(ws + OFF_YS);
  const unsigned char* gates = (const unsigned char*)(ws + OFF_GATES);
  bf16_t* merged = (bf16_t*)(ws + OFF_QQ);
  const int lane = tidx() & 63, w = tidx() >> 6;
  const int r = lane & 31, hh = lane >> 5, wm = w & 1, wn = w >> 1;
  for (int id = blockIdx.x; id < 128 * 8; id += gridDim.x) {
    const int m0 = (id >> 3) * 128, n0 = (id & 7) * 128;
    f32x16 mg[2][2];
    zero_acc<2>(mg);
#pragma unroll 1
    for (int n = 0; n < 3; n++) {
      f32x16 acc[2][2];
      zero_acc<2>(acc);
      gemm_mainloop<2>(ys + (size_t)n * T * 512 + (size_t)m0 * 512, 512, Wb + (size_t)(n * 1024 + n0) * 512, 512, 512, smem, acc);
      unsigned char* sG = (unsigned char*)smem;
      __syncthreads();
      {
        const int tid = tidx();
#pragma unroll
        for (int j = 0; j < 4; j++) {
          const int c = tid + 256 * j;
          const int row = c >> 3, col = (c & 7) * 16;
          *(uint4*)(sG + row * 144 + col) = *(const uint4*)(gates + (size_t)(m0 + row) * 3072 + n * 1024 + n0 + col);
        }
      }
      __syncthreads();
#pragma unroll
      for (int ni = 0; ni < 2; ni++)
#pragma unroll
        for (int mi = 0; mi < 2; mi++)
#pragma unroll
          for (int g = 0; g < 4; g++) {
            const int ml = wm * 64 + mi * 32 + r;
            const int nl = wn * 64 + ni * 32 + 8 * g + 4 * hh;
            const unsigned gv = *(const unsigned*)(sG + ml * 144 + nl);
            const float k255 = 1.f / 255.f;
            mg[ni][mi][4 * g + 0] = fmaf((float)(gv & 255u) * k255, acc[ni][mi][4 * g + 0], mg[ni][mi][4 * g + 0]);
            mg[ni][mi][4 * g + 1] = fmaf((float)((gv >> 8) & 255u) * k255, acc[ni][mi][4 * g + 1], mg[ni][mi][4 * g + 1]);
            mg[ni][mi][4 * g + 2] = fmaf((float)((gv >> 16) & 255u) * k255, acc[ni][mi][4 * g + 2], mg[ni][mi][4 * g + 2]);
            mg[ni][mi][4 * g + 3] = fmaf((float)(gv >> 24) * k255, acc[ni][mi][4 * g + 3], mg[ni][mi][4 * g + 3]);
          }
    }
    {
      bf16_t* sT = (bf16_t*)smem;
      __syncthreads();
      gemm_epilogue<2>(mg, [&](int ml, int nl, f32x4 v) {
        uint2 pk = {pack2(v[0], v[1]), pack2(v[2], v[3])};
        *(uint2*)(sT + ml * 136 + nl) = pk;
      });
      __syncthreads();
      const int tid = tidx();
#pragma unroll
      for (int j = 0; j < 8; j++) {
        const int c = tid + 256 * j;
        const int row = c >> 4, col = (c & 15) * 8;
        *(uint4*)(merged + (size_t)(m0 + row) * 1024 + n0 + col) = *(const uint4*)(sT + row * 136 + col);
      }
    }
  }
}

DEVI void phaseG(const Params& p, int l, char* smem) {
  char* ws = p.ws;
  const bf16_t* merged = (const bf16_t*)(ws + OFF_QQ);
  const bf16_t* W = (const bf16_t*)(ws + OFF_WOUT) + (size_t)l * 1024 * 1024;
  bf16_t* xb = (bf16_t*)(ws + OFF_XB);
  float* rowsq = (float*)(ws + OFF_ROWSQ);
  float* sSq = (float*)(smem + 2 * 128 * GLD * 2);
  const int lane = tidx() & 63, w = tidx() >> 6;
  const int r = lane & 31, hh = lane >> 5, wm = w & 1, wn = w >> 1;
  for (int id = blockIdx.x; id < 128 * 8; id += gridDim.x) {
    const int m0 = (id >> 3) * 128, nt = id & 7, n0 = nt * 128;
    f32x16 acc[2][2];
    zero_acc<2>(acc);
    gemm_mainloop<2>(merged + (size_t)m0 * 1024, 1024, W + (size_t)n0 * 1024, 1024, 1024, smem, acc);
    float sq[2] = {0.f, 0.f};
#pragma unroll
    for (int ni = 0; ni < 2; ni++)
#pragma unroll
      for (int mi = 0; mi < 2; mi++)
#pragma unroll
        for (int g = 0; g < 4; g++) {
          const size_t m = m0 + wm * 64 + mi * 32 + r;
          const int n = n0 + wn * 64 + ni * 32 + 8 * g + 4 * hh;
          float4 xo = *(const float4*)(p.out + m * 1024 + n);
          xo.x += acc[ni][mi][4 * g]; xo.y += acc[ni][mi][4 * g + 1];
          xo.z += acc[ni][mi][4 * g + 2]; xo.w += acc[ni][mi][4 * g + 3];
          *(float4*)(p.out + m * 1024 + n) = xo;
          uint2 pk = {pack2(xo.x, xo.y), pack2(xo.z, xo.w)};
          *(uint2*)(xb + m * 1024 + n) = pk;
          sq[mi] += xo.x * xo.x + xo.y * xo.y + xo.z * xo.z + xo.w * xo.w;
        }
    sq[0] += shx32(sq[0]);
    sq[1] += shx32(sq[1]);
    __syncthreads();
    if (hh == 0) {
      sSq[wn * 128 + wm * 64 + r] = sq[0];
      sSq[wn * 128 + wm * 64 + 32 + r] = sq[1];
    }
    __syncthreads();
    if (tidx() < 128) rowsq[(size_t)(m0 + tidx()) * 8 + nt] = sSq[tidx()] + sSq[128 + tidx()];
  }
}

DEVI void phase_final(const Params& p) {
  const float* rowsq = (const float*)(p.ws + OFF_ROWSQ);
  const int lane = tidx() & 63, w = tidx() >> 6;
  for (int row = blockIdx.x * 4 + w; row < T; row += gridDim.x * 4) {
    const float4 a = *(const float4*)(rowsq + (size_t)row * 8);
    const float4 b = *(const float4*)(rowsq + (size_t)row * 8 + 4);
    const float s = ((a.x + a.y) + (a.z + a.w)) + ((b.x + b.y) + (b.z + b.w));
    const float rs = rsqrtf(s * (1.f / 1024.f) + EPS);
#pragma unroll
    for (int i = 0; i < 4; i++) {
      float4 v = *(const float4*)(p.out + (size_t)row * 1024 + i * 256 + lane * 4);
      const float4 g = *(const float4*)(p.in[25] + i * 256 + lane * 4);
      v.x *= rs * g.x; v.y *= rs * g.y; v.z *= rs * g.z; v.w *= rs * g.w;
      *(float4*)(p.out + (size_t)row * 1024 + i * 256 + lane * 4) = v;
    }
  }
}


DEVI void gsync(cg::grid_group& grid) {
  __builtin_amdgcn_fence(__ATOMIC_RELEASE, "agent");
  asm volatile("s_waitcnt vmcnt(0)" ::: "memory");
  grid.sync();
  __builtin_amdgcn_fence(__ATOMIC_ACQUIRE, "agent");
  asm volatile("s_waitcnt vmcnt(0)" ::: "memory");
}
DEVI void gbar(unsigned* ctr, unsigned& epoch) {
  asm volatile("s_waitcnt vmcnt(0)" ::: "memory");
  __syncthreads();
  epoch += 8;
  if (tidx() == 0) {
    __builtin_amdgcn_fence(__ATOMIC_RELEASE, "agent");
    asm volatile("s_waitcnt vmcnt(0)" ::: "memory");
    const unsigned g = blockIdx.x & 7u;
    const unsigned per = (gridDim.x + 7u - g) >> 3;
    const unsigned old = __hip_atomic_fetch_add(ctr + 32 * (1 + g), 1u, __ATOMIC_RELAXED, __HIP_MEMORY_SCOPE_AGENT);
    if ((old + 1u) % per == 0u)
      __hip_atomic_fetch_add(ctr, 1u, __ATOMIC_RELAXED, __HIP_MEMORY_SCOPE_AGENT);
    while (__hip_atomic_load(ctr, __ATOMIC_RELAXED, __HIP_MEMORY_SCOPE_AGENT) < epoch) __builtin_amdgcn_s_sleep(2);
    __builtin_amdgcn_fence(__ATOMIC_ACQUIRE, "agent");
    asm volatile("s_waitcnt vmcnt(0)" ::: "memory");
  }
  __syncthreads();
}
__global__ void __launch_bounds__(256, 2) fwd_megakernel(Params p) {
  cg::grid_group grid = cg::this_grid();
  __shared__ __attribute__((aligned(16))) char smem[SMEM_BYTES];
  const int G = gridDim.x;
  unsigned* bar_ctr = (unsigned*)(p.ws + OFF_BAR);
  unsigned bar_epoch = 0;
  if (blockIdx.x == 0 && tidx() < 9) __hip_atomic_store(bar_ctr + 32 * tidx(), 0u, __ATOMIC_RELAXED, __HIP_MEMORY_SCOPE_AGENT);
  if (blockIdx.x == 0 && tidx() < 8) __hip_atomic_store((unsigned*)(p.ws + OFF_KMAX) + tidx(), 0u, __ATOMIC_RELAXED, __HIP_MEMORY_SCOPE_AGENT);
  phase0(p, smem);
  gsync(grid);
  for (int l = 0; l < DEPTH; l++) {
    phase1(p, l, smem);
    gbar(bar_ctr, bar_epoch);
    s5_chunk_tasks<0>(p, l, smem);
    gbar(bar_ctr, bar_epoch);
    for (int id = blockIdx.x; id < 1024; id += G) mlstm_local(p, l, id, smem);
    for (int id = blockIdx.x; id < 1024; id += G) qq_tile(p, l, id, smem);
    for (int id = blockIdx.x; id < T / 64; id += G) kiv_task(p, l, id, smem);
    gbar(bar_ctr, bar_epoch);
    for (int cid = blockIdx.x; cid < 88; cid += G) {
      if (cid < 72) mlstm_carry(p, cid, smem);
      else s5_carry(p, l, (cid - 72) * 256 + tidx());
    }
    gbar(bar_ctr, bar_epoch);
    for (int id = blockIdx.x; id < 1024; id += G) mlstm_out(p, l, id, smem);
    for (int id = blockIdx.x; id < 512; id += G) {
#pragma unroll 1
      for (int k = 0; k < 2; k++) {
        const int rank = k ? (1023 - id) : id;
        const int b = rank & 1, qb = 511 - (rank >> 1);
        dsa_task(p, l, b, qb * QB, smem);
      }
    }
    gbar(bar_ctr, bar_epoch);
    s5_chunk_tasks<1>(p, l, smem);
    gbar(bar_ctr, bar_epoch);
    phaseE(p, l, smem);
    gbar(bar_ctr, bar_epoch);
    phaseF(p, l, smem);
    gbar(bar_ctr, bar_epoch);
    phaseG(p, l, smem);
    gbar(bar_ctr, bar_epoch);
  }
  phase_final(p);
}

extern "C" void kernel_launch(void* const* d_in, const int* in_sizes, int n_in, void* d_out, int out_size, void* d_ws,
                              size_t ws_size, hipStream_t stream) {
  static int grid_blocks = 0;
  if (!grid_blocks) {
    int dev = 0, cus = 0, per_cu = 0;
    (void)hipGetDevice(&dev);
    (void)hipDeviceGetAttribute(&cus, hipDeviceAttributeMultiprocessorCount, dev);
    (void)hipOccupancyMaxActiveBlocksPerMultiprocessor(&per_cu, fwd_megakernel, 256, 0);
    if (per_cu > 2) per_cu = 2;
    if (per_cu < 1) per_cu = 1;
    grid_blocks = cus * per_cu;
  }
  if (ws_size < WS_TOTAL) {
    fprintf(stderr, "workspace too small: %zu < %zu\n", ws_size, (size_t)WS_TOTAL);
    return;
  }
  Params p{};
  for (int i = 0; i < 26; i++) p.in[i] = (const float*)d_in[i];
  p.out = (float*)d_out;
  p.ws = (char*)d_ws;
  void* args[] = {&p};
  hipError_t e = hipLaunchCooperativeKernel((void*)fwd_megakernel, dim3(grid_blocks), dim3(256), args, 0, stream);
  if (e != hipSuccess) fprintf(stderr, "cooperative launch failed: %s (grid %d)\n", hipGetErrorString(e), grid_blocks);
}
```
